# Optimizing an MI355X kernel written in HIP

```python
import math
import jax, jax.numpy as jnp
from jax import lax
import numpy as np

D_MODEL = 1024
BATCH = 16
SEQ = 4096
DEPTH = 1
DEC_BATCH = 8
DEC_SEQ = 16
PAST_LEN = 1024

CHUNK = 64
N_HEADS = 8
QK_NOPE = 128
QK_ROPE = 64
QK_HEAD = QK_NOPE + QK_ROPE
V_HEAD = 128
Q_LORA = 512
KV_LORA = 512
ROPE_THETA = 10000.0
SCALE = QK_HEAD ** -0.5
Q_BLOCK = 128
NEG_INF = -1e30
D_RNN = D_MODEL
RNN_BLOCKS = 8
RNN_BLOCK = D_RNN // RNN_BLOCKS
CONV_W = 4
LRU_C = 8.0
D_FF = -(-8 * D_MODEL // (3 * 256)) * 256
EPS = 1e-6
OFF_Q = 0
OFF_KV = OFF_Q + Q_LORA
OFF_KR = OFF_KV + KV_LORA
OFF_X = OFF_KR + QK_ROPE
OFF_GA = OFF_X + D_RNN
OFF_GB = OFF_GA + D_MODEL
IN_TOTAL = OFF_GB + D_MODEL

kernel_name = 'hybrid_mla_rglru_stream_step'


def rms_norm(x, g):
    xf = x.astype(jnp.float32)
    y = xf * lax.rsqrt(jnp.mean(xf * xf, axis=-1, keepdims=True) + EPS)
    return (y * g.astype(jnp.float32)).astype(x.dtype)


def apply_rope(x, pos):
    half = QK_ROPE // 2
    inv_freq = jnp.exp(-math.log(ROPE_THETA) * jnp.arange(half, dtype=jnp.float32) / half)
    ang = pos.astype(jnp.float32)[:, None] * inv_freq[None, :]
    cos = jnp.cos(ang)[None, :, None, :]
    sin = jnp.sin(ang)[None, :, None, :]
    xf = x.astype(jnp.float32)
    x1, x2 = xf[..., :half], xf[..., half:]
    return jnp.concatenate([x1 * cos - x2 * sin, x1 * sin + x2 * cos], axis=-1).astype(x.dtype)


def mla_queries(c_q, pos, q_norm_g, w_uq, qk_q_g):
    b, t, _ = c_q.shape
    q = (rms_norm(c_q, q_norm_g) @ w_uq).reshape(b, t, N_HEADS, QK_HEAD)
    q = rms_norm(q, qk_q_g)
    return jnp.concatenate([q[..., :QK_NOPE], apply_rope(q[..., QK_NOPE:], pos)], axis=-1)


def mla_keys_values(c_kv, k_rope_raw, pos, w_ukv, qk_k_g):
    b, t, _ = c_kv.shape
    kv = (c_kv @ w_ukv).reshape(b, t, N_HEADS, QK_NOPE + V_HEAD)
    k_rope = jnp.broadcast_to(k_rope_raw[:, :, None, :], (b, t, N_HEADS, QK_ROPE))
    k = rms_norm(jnp.concatenate([kv[..., :QK_NOPE], k_rope], axis=-1), qk_k_g)
    k = jnp.concatenate([k[..., :QK_NOPE], apply_rope(k[..., QK_NOPE:], pos)], axis=-1)
    return k, kv[..., QK_NOPE:]


def chunk_causal_attend(q, q_pos, k, v, k_pos):
    s = jnp.einsum('bqhd,bkhd->bhqk', q, k, preferred_element_type=jnp.float32) * SCALE
    allowed = (k_pos[None, :] // CHUNK) <= (q_pos[:, None] // CHUNK)
    s = jnp.where(allowed[None, None], s, NEG_INF)
    p = jax.nn.softmax(s, axis=-1).astype(v.dtype)
    return jnp.einsum('bhqk,bkhd->bqhd', p, v)


def blocked_prompt_attention(q, k, v, pos):
    b, t, h, dk = q.shape
    nb = t // Q_BLOCK
    q_blocks = q.reshape(b, nb, Q_BLOCK, h, dk).transpose(1, 0, 2, 3, 4)
    pos_blocks = pos.reshape(nb, Q_BLOCK)
    out = lax.map(lambda qp: chunk_causal_attend(qp[0], qp[1], k, v, pos), (q_blocks, pos_blocks))
    return out.transpose(1, 0, 2, 3, 4).reshape(b, t, h, V_HEAD)


def causal_depthwise_conv(x, hist, w, bias):
    t = x.shape[1]
    xp = jnp.concatenate([hist, x], axis=1)
    y = bias + xp[:, 0:t] * w[0]
    for j in range(1, CONV_W):
        y = y + xp[:, j:j + t] * w[j]
    return y, xp[:, xp.shape[1] - (CONV_W - 1):]


def rg_lru(xc, h0, w_a, b_a, w_x, b_x, lam):
    b, t, c = xc.shape
    xb = xc.reshape(b, t, RNN_BLOCKS, RNN_BLOCK)
    r = jax.nn.sigmoid((jnp.einsum('btni,nij->btnj', xb, w_a).reshape(b, t, c) + b_a).astype(jnp.float32))
    i = jax.nn.sigmoid((jnp.einsum('btni,nij->btnj', xb, w_x).reshape(b, t, c) + b_x).astype(jnp.float32))
    log_a = -LRU_C * r * jax.nn.softplus(-lam.astype(jnp.float32))
    a = jnp.exp(log_a)
    u = jnp.sqrt(-jnp.expm1(2.0 * log_a)) * (i * xc.astype(jnp.float32))
    u = u.at[:, 0].add(a[:, 0] * h0.astype(jnp.float32))

    def combine(left, right):
        a_l, u_l = left
        a_r, u_r = right
        return a_l * a_r, a_r * u_l + u_r

    _, h = lax.associative_scan(combine, (a, u), axis=1)
    return h.astype(xc.dtype), h[:, -1].astype(xc.dtype)


def hybrid_layer(x, pos, past, p):
    b, t, _ = x.shape
    xn = rms_norm(x, p['norm1_g'])
    z = xn @ p['w_in']
    c_q = z[..., OFF_Q:OFF_KV]
    c_kv = rms_norm(z[..., OFF_KV:OFF_KR], p['kv_norm_g'])
    k_rope_raw = z[..., OFF_KR:OFF_X]
    x_rnn = z[..., OFF_X:OFF_GA]
    g_att = z[..., OFF_GA:OFF_GB]
    g_rnn = z[..., OFF_GB:IN_TOTAL]

    q = mla_queries(c_q, pos, p['q_norm_g'], p['w_uq'], p['qk_q_g'])
    if past is None:
        k, v = mla_keys_values(c_kv, k_rope_raw, pos, p['w_ukv'], p['qk_k_g'])
        att = blocked_prompt_attention(q, k, v, pos)
        conv_hist = jnp.zeros((b, CONV_W - 1, D_RNN), x.dtype)
        h0 = jnp.zeros((b, D_RNN), x.dtype)
    else:
        past_ckv, past_krope, past_pos, conv_hist, h0 = past
        k_pos = jnp.concatenate([past_pos, pos])
        k, v = mla_keys_values(jnp.concatenate([past_ckv, c_kv], axis=1),
                               jnp.concatenate([past_krope, k_rope_raw], axis=1),
                               k_pos, p['w_ukv'], p['qk_k_g'])
        att = chunk_causal_attend(q, pos, k, v, k_pos)

    xc, conv_new = causal_depthwise_conv(x_rnn, conv_hist, p['conv_w'], p['conv_b'])
    h_seq, h_last = rg_lru(xc, h0, p['w_rg_a'], p['b_rg_a'], p['w_rg_x'], p['b_rg_x'], p['lru_lambda'])

    o_att = att.reshape(b, t, N_HEADS * V_HEAD) @ p['w_proj_attn']
    o_rnn = h_seq @ p['w_proj_rnn']
    merged = jax.nn.sigmoid(g_att) * o_att + jax.nn.sigmoid(g_rnn) * o_rnn
    x = x + merged @ p['w_out']

    xn2 = rms_norm(x, p['norm2_g'])
    x = x + (jax.nn.silu(xn2 @ p['w_ffn_gate']) * (xn2 @ p['w_ffn_up'])) @ p['w_ffn_down']
    return x, c_kv, k_rope_raw, conv_new, h_last


def setup_inputs(seed: int = 0) -> dict:
    key = jax.random.key(seed)
    ks = jax.random.split(key, 32)

    def nrm(k, shape, scale):
        return jax.random.normal(k, shape, jnp.float32) * scale

    u = jax.random.uniform(ks[20], (DEPTH, D_RNN), jnp.float32, minval=0.9, maxval=0.999)
    a_base = u ** (1.0 / LRU_C)
    lru_lambda = jnp.log(a_base) - jnp.log1p(-a_base)
    return {
        'x_prompt': nrm(ks[0], (BATCH, SEQ, D_MODEL), 1.0),
        'x_sample': nrm(ks[1], (DEC_BATCH, DEC_SEQ, D_MODEL), 1.0),
        'cache_ckv': nrm(ks[2], (DEPTH, DEC_BATCH, PAST_LEN, KV_LORA), 1.0),
        'cache_krope': nrm(ks[3], (DEPTH, DEC_BATCH, PAST_LEN, QK_ROPE), 1.0),
        'state_conv': nrm(ks[4], (DEPTH, DEC_BATCH, CONV_W - 1, D_RNN), 1.0),
        'state_h': nrm(ks[5], (DEPTH, DEC_BATCH, D_RNN), 0.5),
        'norm1_g': 1.0 + nrm(ks[6], (DEPTH, D_MODEL), 0.02),
        'w_in': nrm(ks[7], (DEPTH, D_MODEL, IN_TOTAL), D_MODEL ** -0.5),
        'q_norm_g': 1.0 + nrm(ks[8], (DEPTH, Q_LORA), 0.02),
        'w_uq': nrm(ks[9], (DEPTH, Q_LORA, N_HEADS * QK_HEAD), Q_LORA ** -0.5),
        'kv_norm_g': 1.0 + nrm(ks[10], (DEPTH, KV_LORA), 0.02),
        'w_ukv': nrm(ks[11], (DEPTH, KV_LORA, N_HEADS * (QK_NOPE + V_HEAD)), KV_LORA ** -0.5),
        'qk_q_g': 1.0 + nrm(ks[12], (DEPTH, QK_HEAD), 0.02),
        'qk_k_g': 1.0 + nrm(ks[13], (DEPTH, QK_HEAD), 0.02),
        'conv_w': nrm(ks[14], (DEPTH, CONV_W, D_RNN), CONV_W ** -0.5),
        'conv_b': nrm(ks[15], (DEPTH, D_RNN), 0.02),
        'w_rg_a': nrm(ks[16], (DEPTH, RNN_BLOCKS, RNN_BLOCK, RNN_BLOCK), RNN_BLOCK ** -0.5),
        'b_rg_a': nrm(ks[17], (DEPTH, D_RNN), 0.02),
        'w_rg_x': nrm(ks[18], (DEPTH, RNN_BLOCKS, RNN_BLOCK, RNN_BLOCK), RNN_BLOCK ** -0.5),
        'b_rg_x': nrm(ks[19], (DEPTH, D_RNN), 0.02),
        'lru_lambda': lru_lambda,
        'w_proj_attn': nrm(ks[21], (DEPTH, N_HEADS * V_HEAD, D_MODEL), (N_HEADS * V_HEAD) ** -0.5),
        'w_proj_rnn': nrm(ks[22], (DEPTH, D_RNN, D_MODEL), D_RNN ** -0.5),
        'w_out': nrm(ks[23], (DEPTH, D_MODEL, D_MODEL), D_MODEL ** -0.5),
        'norm2_g': 1.0 + nrm(ks[24], (DEPTH, D_MODEL), 0.02),
        'w_ffn_gate': nrm(ks[25], (DEPTH, D_MODEL, D_FF), D_MODEL ** -0.5),
        'w_ffn_up': nrm(ks[26], (DEPTH, D_MODEL, D_FF), D_MODEL ** -0.5),
        'w_ffn_down': nrm(ks[27], (DEPTH, D_FF, D_MODEL), D_FF ** -0.5),
    }


def reference(x_prompt, x_sample, cache_ckv, cache_krope, state_conv, state_h,
              norm1_g, w_in, q_norm_g, w_uq, kv_norm_g, w_ukv, qk_q_g, qk_k_g,
              conv_w, conv_b, w_rg_a, b_rg_a, w_rg_x, b_rg_x, lru_lambda,
              w_proj_attn, w_proj_rnn, w_out, norm2_g, w_ffn_gate, w_ffn_up, w_ffn_down):
    past_len = cache_ckv.shape[2]
    pos_prompt = jnp.arange(x_prompt.shape[1], dtype=jnp.int32)
    past_pos = jnp.arange(past_len, dtype=jnp.int32)
    pos_sample = past_len + jnp.arange(x_sample.shape[1], dtype=jnp.int32)

    y_p, y_s = x_prompt, x_sample
    ckv_p, kr_p, conv_p, h_p = [], [], [], []
    ckv_s, kr_s, conv_s, h_s = [], [], [], []
    for l in range(DEPTH):
        p = dict(norm1_g=norm1_g[l], w_in=w_in[l], q_norm_g=q_norm_g[l], w_uq=w_uq[l],
                 kv_norm_g=kv_norm_g[l], w_ukv=w_ukv[l], qk_q_g=qk_q_g[l], qk_k_g=qk_k_g[l],
                 conv_w=conv_w[l], conv_b=conv_b[l], w_rg_a=w_rg_a[l], b_rg_a=b_rg_a[l],
                 w_rg_x=w_rg_x[l], b_rg_x=b_rg_x[l], lru_lambda=lru_lambda[l],
                 w_proj_attn=w_proj_attn[l], w_proj_rnn=w_proj_rnn[l], w_out=w_out[l],
                 norm2_g=norm2_g[l], w_ffn_gate=w_ffn_gate[l], w_ffn_up=w_ffn_up[l],
                 w_ffn_down=w_ffn_down[l])
        y_p, c1, k1, v1, h1 = hybrid_layer(y_p, pos_prompt, None, p)
        past = (cache_ckv[l], cache_krope[l], past_pos, state_conv[l], state_h[l])
        y_s, c2, k2, v2, h2 = hybrid_layer(y_s, pos_sample, past, p)
        ckv_p.append(c1); kr_p.append(k1); conv_p.append(v1); h_p.append(h1)
        ckv_s.append(c2); kr_s.append(k2); conv_s.append(v2); h_s.append(h2)

    new_ckv_prompt = jnp.stack(ckv_p)
    new_krope_prompt = jnp.stack(kr_p)
    new_conv_prompt = jnp.stack(conv_p)
    new_h_prompt = jnp.stack(h_p)
    new_ckv_sample = jnp.stack(ckv_s)
    new_krope_sample = jnp.stack(kr_s)
    new_conv_sample = jnp.stack(conv_s)
    new_h_sample = jnp.stack(h_s)
    return (y_p, y_s, new_ckv_prompt, new_krope_prompt, new_conv_prompt, new_h_prompt,
            new_ckv_sample, new_krope_sample, new_conv_sample, new_h_sample)
```

```cpp
#include <hip/hip_runtime.h>
#include <hip/hip_cooperative_groups.h>
#include <cstdio>
namespace cg = cooperative_groups;

#define LAS __attribute__((address_space(3)))
typedef unsigned short bf16_t;
typedef short bf16x8 __attribute__((ext_vector_type(8)));
typedef float f32x4 __attribute__((ext_vector_type(4)));
typedef float f32x2 __attribute__((ext_vector_type(2)));
typedef float f32x16 __attribute__((ext_vector_type(16)));
typedef unsigned u32x4 __attribute__((ext_vector_type(4)));
typedef unsigned u32x2 __attribute__((ext_vector_type(2)));

constexpr int DM = 1024, NB = 16, SEQ = 4096, MP = NB * SEQ;
constexpr int SB = 8, ST = 16, MS = SB * ST, PAST = 1024;
constexpr int MT = 65792;
constexpr int MKV = 73984;
constexpr int R_PAST0 = MT;
constexpr int NIN = 4352;
constexpr int DFF = 2816;
constexpr float EPS = 1e-6f;
constexpr float QSCALE = 0.07216878364870322f * 1.4426950408889634f;

constexpr size_t O_YP = 0, O_YS = O_YP + (size_t)MP * DM, O_CKVP = O_YS + (size_t)MS * DM, O_KRP = O_CKVP + (size_t)MP * 512, O_CONVP = O_KRP + (size_t)MP * 64,
                 O_HP = O_CONVP + (size_t)NB * 3 * DM, O_CKVS = O_HP + (size_t)NB * DM, O_KRS = O_CKVS + (size_t)MS * 512, O_CONVS = O_KRS + (size_t)MS * 64,
                 O_HS = O_CONVS + (size_t)SB * 3 * DM, O_END = O_HS + (size_t)SB * DM;

constexpr size_t al256(size_t x) { return (x + 255) & ~(size_t)255; }
constexpr size_t W_IN = 0;
constexpr size_t W_UQ = W_IN + (size_t)NIN * 1024 * 2;
constexpr size_t W_UK = W_UQ + (size_t)2048 * 512 * 2;
constexpr size_t W_UV = W_UK + (size_t)1024 * 512 * 2;
constexpr size_t W_PA = W_UV + (size_t)1024 * 512 * 2;
constexpr size_t W_PR = W_PA + (size_t)1024 * 1024 * 2;
constexpr size_t W_OUT = W_PR + (size_t)1024 * 1024 * 2;
constexpr size_t W_GU = W_OUT + (size_t)1024 * 1024 * 2;
constexpr size_t W_D = W_GU + (size_t)5632 * 1024 * 2;
constexpr size_t W_RA = W_D + (size_t)1024 * DFF * 2;
constexpr size_t W_RX = W_RA + (size_t)8 * 128 * 128 * 2;
constexpr size_t W_CS = W_RX + (size_t)8 * 128 * 128 * 2;
constexpr size_t W_SSQ0 = W_CS + (size_t)4096 * 32 * 8;
constexpr size_t W_SSQ_CQ = W_SSQ0;
constexpr size_t W_SSQ_CKV = W_SSQ_CQ + (size_t)MT * 4;
constexpr size_t W_SSQ_Q = W_SSQ_CKV + (size_t)MT * 4;
constexpr size_t W_SSQ_K = W_SSQ_Q + (size_t)MT * 8 * 4;
constexpr size_t W_SSQ2 = W_SSQ_K + (size_t)MKV * 8 * 4;
constexpr size_t W_SSQ_END = W_SSQ2 + (size_t)MT * 4;
constexpr size_t W_SSQ_KR = W_SSQ_END;
constexpr size_t W_KR = al256(W_SSQ_KR + (size_t)MKV * 4);
constexpr size_t W_GS = al256(W_KR + (size_t)MKV * 64 * 2);
constexpr size_t W_BAR = al256(W_GS + (size_t)2 * 256 * 1024 * 2);
constexpr size_t R_A = al256(W_BAR + 16384);
constexpr size_t R_B = R_A + (size_t)MT * 1024 * 2;
constexpr size_t R_F = R_B + (size_t)MT * 1024 * 2;
constexpr size_t R_G = R_F + (size_t)MKV * 1024 * 2;
constexpr size_t R_C = R_G + (size_t)MKV * 1024 * 2;
constexpr size_t R_D = R_C + (size_t)MT * 512 * 2;
constexpr size_t R_E = R_D + (size_t)MKV * 512 * 2;
constexpr size_t R_H = R_E + (size_t)MT * 1024 * 2;
constexpr size_t WS_END = R_H + (size_t)MT * 1024 * 2;
static_assert((size_t)MT * 1536 * 2 <= R_F - R_A, "Q' overlay");
static_assert((size_t)MT * DFF * 2 <= R_G - R_A, "hidden overlay");
static_assert((size_t)MT * 1024 * 2 <= R_E - R_C, "merged overlay");

constexpr int LDS_BYTES = 131072 + 64, L_XB = 131072;

struct Params {
    const float *x_p, *x_s, *cache_ckv, *cache_kr, *state_conv, *state_h, *norm1_g, *w_in, *q_norm_g, *w_uq, *kv_norm_g, *w_ukv, *qk_q_g, *qk_k_g, *conv_w, *conv_b,
        *w_rg_a, *b_rg_a, *w_rg_x, *b_rg_x, *lam, *w_pa, *w_pr, *w_out, *norm2_g, *w_fg, *w_fu, *w_fd;
    float* out; unsigned char* ws;
};

typedef __bf16 bf16x2_t __attribute__((ext_vector_type(2)));
__device__ __forceinline__ unsigned pk2(float lo, float hi) { bf16x2_t v = {(__bf16)lo, (__bf16)hi}; return __builtin_bit_cast(unsigned, v); }
__device__ __forceinline__ float bflo(unsigned u) { return __uint_as_float(u << 16); }
__device__ __forceinline__ float bfhi(unsigned u) { return __uint_as_float(u & 0xffff0000u); }
__device__ __forceinline__ float bf1(bf16_t b) { return __uint_as_float(((unsigned)b) << 16); }
__device__ __forceinline__ float wave_sum(float v) {
#pragma unroll
    for (int o = 1; o < 64; o <<= 1) v += __shfl_xor(v, o);
    return v;
}
__device__ __forceinline__ float sigmoidf_(float x) { return __builtin_amdgcn_rcpf(1.0f + __builtin_amdgcn_exp2f(-1.4426950408889634f * x)); }
__device__ __forceinline__ int my_tid() { int t = threadIdx.x; asm volatile("" : "+v"(t)); return t; }
#define LDS_WAIT() asm volatile("s_waitcnt lgkmcnt(0)" ::: "memory")
__device__ __forceinline__ int tok_pos(int R) { return R < MP ? (R & (SEQ - 1)) : (PAST + ((R - MP) & (ST - 1))); }
__device__ __forceinline__ f32x2 rope_cs(int pos, int i) {
    const float inv = (float)exp(-9.210340371976184 * (double)i / 32.0);
    const float ang = (float)pos * inv;
    const double a = (double)ang; const double k = rint(a * 0.15915494309189535); const float r = (float)(a - k * 6.283185307179586);
    f32x2 o; o.x = cosf(r); o.y = sinf(r); return o;
}

namespace pg8 {
constexpr int BM = 256, BK = 64, HALF = 128, HTB = HALF * BK * 2, STAGE_BYTES = 8 * HTB, NXCD = 8, WGM = 8;
__device__ __forceinline__ int lds_byte(int r, int c) { const int st = (r >> 4) * 2 + (c >> 5), rr = r & 15, cc = c & 31, ob = rr * 64 + cc * 2; return st * 1024 + (ob ^ (((ob >> 9) & 1) << 5)); }
__device__ __forceinline__ void stage_rc(int b, int& R, int& C) { const int st = b / 1024, sb = b % 1024, swz = sb ^ (((sb >> 9) & 1) << 5); R = (st >> 1) * 16 + swz / 64; C = (st & 1) * 32 + (swz % 64) / 2; }
__device__ __forceinline__ int perm32(int rho) { const int n = rho >> 4, i = rho & 15; return 8 * (i >> 2) + 4 * n + (i & 3); }
struct Unit { int pm, pn, g; };
__device__ __forceinline__ void tile_of(int wgid, int nM, int nN, int& pm, int& pn) {
    const int nwg = nM * nN;
    { const int q = nwg / NXCD, r = nwg % NXCD, xcd = wgid % NXCD, off = wgid / NXCD; wgid = (xcd < r ? xcd * (q + 1) : r * (q + 1) + (xcd - r) * q) + off; }
    const int nig = WGM * nN, gid = wgid / nig, fm = gid * WGM, gsz = (nM - fm) < WGM ? (nM - fm) : WGM;
    pm = fm + ((wgid % nig) % gsz); pn = (wgid % nig) / gsz;
}
template <int NG, int UPT, size_t A0, size_t B0, int nM0, int nN0, size_t A1 = 0, size_t B1 = 0, int nM1 = 0, int nN1 = 0, size_t A2 = 0, size_t B2 = 0, int nM2 = 0, int nN2 = 0> struct Order {
    const unsigned char* ws; int G, c;
    __device__ __forceinline__ bool next(int i, Unit& u) const {
        int L = (i / UPT) * G + c;
        constexpr int n0 = nM0 * nN0, n1 = nM1 * nN1, n2 = nM2 * nN2;
        if (L < n0) { tile_of(L, nM0, nN0, u.pm, u.pn); u.g = (UPT > 1) ? (i % UPT) : 0; return true; }
        if constexpr (NG > 1) { L -= n0; if (L < n1) { tile_of(L, nM1, nN1, u.pm, u.pn); u.g = 1; return true; }
            if constexpr (NG > 2) { L -= n1; if (L < n2) { tile_of(L, nM2, nN2, u.pm, u.pn); u.g = 2; return true; } } }
        return false;
    }
    __device__ __forceinline__ const char* a_of(const Unit& u) const { size_t o = A0; if constexpr (NG > 1 || UPT > 1) o = (u.g == 1) ? A1 : o; if constexpr (NG > 2) o = (u.g == 2) ? A2 : o; return (const char*)ws + o; }
    __device__ __forceinline__ const char* b_of(const Unit& u) const { size_t o = B0; if constexpr (NG > 1 || UPT > 1) o = (u.g == 1) ? B1 : o; if constexpr (NG > 2) o = (u.g == 2) ? B2 : o; return (const char*)ws + o; }
};

template <class Epi, class Sched>
__device__ __forceinline__ void gemm_phase(LAS unsigned char* lds, const int K, const Sched& S, const Epi& E) {
    const int tid = my_tid(), wid = __builtin_amdgcn_readfirstlane(tid >> 6), lane = tid & 63, wr = wid >> 2, wc = wid & 3, fr = lane & 15, fq = lane >> 4;
    const int nt = K / BK;
    unsigned voffA[2], voffB[2];
#pragma unroll
    for (int i = 0; i < 2; ++i) { int R, C; stage_rc(tid * 16 + i * 8192, R, C); const int Rb = (R & ~31) + perm32(R & 31);
        voffA[i] = (unsigned)(R * K + C) * 2u; voffB[i] = (unsigned)(Rb * K + C) * 2u; }
    const size_t kstep = (size_t)(BK * 2);
    const size_t hstep = (size_t)HALF * K * 2;
    const size_t tstep = 2 * hstep;
    const unsigned ldsw = (unsigned)wid * 1024u;
    const int aoff = lds_byte(wr * 64 + fr, fq * 8), boff = lds_byte(wc * 32 + fr, fq * 8);
#define PG8_SA(b, h) (((b) * 2 + (h)) * HTB)
#define PG8_SB(b, h) ((4 + (b) * 2 + (h)) * HTB)
#define PG8_STAGE(bufoff, gbase, voff) do { _Pragma("unroll") for (int _i = 0; _i < 2; ++_i) \
        __builtin_amdgcn_global_load_lds((const unsigned*)((const char*)(gbase) + (voff)[_i]), (LAS unsigned*)(lds + (bufoff) + ldsw + _i * 8192), 16, 0, 0); } while (0)
#define PG8_LDA(dst, b, h) do { _Pragma("unroll") for (int m = 0; m < 4; ++m) _Pragma("unroll") for (int k = 0; k < 2; ++k) dst[m][k] = *(const LAS bf16x8*)(lds + PG8_SA(b, h) + aoff + m * 2048 + k * 1024); } while (0)
#define PG8_LDB(dst, b, h) do { _Pragma("unroll") for (int n = 0; n < 2; ++n) _Pragma("unroll") for (int k = 0; k < 2; ++k) dst[n][k] = *(const LAS bf16x8*)(lds + PG8_SB(b, h) + boff + n * 2048 + k * 1024); } while (0)
#define PG8_MMA(ai, bj, At, Bt) do { __builtin_amdgcn_s_setprio(1); _Pragma("unroll") for (int m = 0; m < 4; ++m) _Pragma("unroll") for (int n = 0; n < 2; ++n) _Pragma("unroll") for (int k = 0; k < 2; ++k) \
        acc[ai][bj][m][n] = __builtin_amdgcn_mfma_f32_16x16x32_bf16(Bt[n][k], At[m][k], acc[ai][bj][m][n], 0, 0, 0); __builtin_amdgcn_s_setprio(0); } while (0)
#define PG8_WAIT_V(n) asm volatile("s_waitcnt vmcnt(" #n ")" ::: "memory")
#define PG8_WAIT_L(n) asm volatile("s_waitcnt lgkmcnt(" #n ")" ::: "memory")
#define PG8_BAR __builtin_amdgcn_s_barrier()
#define PG8_SCHED __builtin_amdgcn_sched_barrier(0)
    Unit cur, nxt; int ui = 0;
    if (!S.next(0, cur)) return;
    f32x4 acc[2][2][4][2];
#pragma unroll
    for (int a = 0; a < 2; ++a)
#pragma unroll
        for (int b = 0; b < 2; ++b)
#pragma unroll
            for (int m = 0; m < 4; ++m)
#pragma unroll
                for (int n = 0; n < 2; ++n) acc[a][b][m][n] = (f32x4){0.f, 0.f, 0.f, 0.f};
    bf16x8 At[4][2], B0[2][2], B1[2][2];
    const char* cA = S.a_of(cur) + (size_t)cur.pm * tstep; const char* cB = S.b_of(cur) + (size_t)cur.pn * tstep;
    PG8_STAGE(PG8_SB(0, 0), cB, voffB); PG8_STAGE(PG8_SA(0, 0), cA, voffA); PG8_STAGE(PG8_SB(0, 1), cB + hstep, voffB); PG8_STAGE(PG8_SA(0, 1), cA + hstep, voffA);
    if (wr == 1) PG8_BAR;
    PG8_WAIT_V(4); PG8_BAR;
    PG8_STAGE(PG8_SB(1, 0), cB + kstep, voffB); PG8_STAGE(PG8_SA(1, 0), cA + kstep, voffA); PG8_STAGE(PG8_SB(1, 1), cB + hstep + kstep, voffB);
    PG8_WAIT_V(6); PG8_BAR;
    for (;;) {
        const bool has_next = S.next(ui + 1, nxt);
        const char* nA = has_next ? S.a_of(nxt) + (size_t)nxt.pm * tstep : cA; const char* nB = has_next ? S.b_of(nxt) + (size_t)nxt.pn * tstep : cB;
        for (int t = 0; t < nt; t += 2) {
            const bool last = (t == nt - 2);
            const char* a1 = cA + (size_t)(t + 1) * kstep;
            const char* a2 = last ? nA : cA + (size_t)(t + 2) * kstep; const char* b2 = last ? nB : cB + (size_t)(t + 2) * kstep;
            const char* a3 = a2 + kstep; const char* b3 = b2 + kstep;
            PG8_LDB(B0, 0, 0); PG8_SCHED; PG8_LDA(At, 0, 0); PG8_STAGE(PG8_SA(1, 1), a1 + hstep, voffA);
            PG8_WAIT_L(8); PG8_BAR; PG8_WAIT_L(0); PG8_MMA(0, 0, At, B0); PG8_BAR; PG8_SCHED;
            PG8_LDB(B1, 0, 1); PG8_STAGE(PG8_SB(0, 0), b2, voffB);
            PG8_BAR; PG8_WAIT_L(0); PG8_MMA(0, 1, At, B1); PG8_BAR;
            PG8_LDA(At, 0, 1); PG8_STAGE(PG8_SA(0, 0), a2, voffA);
            PG8_BAR; PG8_WAIT_L(0); PG8_MMA(1, 0, At, B0); PG8_BAR; PG8_SCHED;
            PG8_STAGE(PG8_SB(0, 1), b2 + hstep, voffB);
            PG8_WAIT_V(6); PG8_BAR; PG8_MMA(1, 1, At, B1); PG8_BAR;
            PG8_LDB(B0, 1, 0); PG8_SCHED; PG8_LDA(At, 1, 0); PG8_STAGE(PG8_SA(0, 1), a2 + hstep, voffA);
            PG8_WAIT_L(8); PG8_BAR; PG8_WAIT_L(0); PG8_MMA(0, 0, At, B0); PG8_BAR; PG8_SCHED;
            PG8_LDB(B1, 1, 1); PG8_STAGE(PG8_SB(1, 0), b3, voffB);
            PG8_BAR; PG8_WAIT_L(0); PG8_MMA(0, 1, At, B1); PG8_BAR;
            PG8_LDA(At, 1, 1); PG8_STAGE(PG8_SA(1, 0), a3, voffA);
            PG8_BAR; PG8_WAIT_L(0); PG8_MMA(1, 0, At, B0); PG8_BAR; PG8_SCHED;
            PG8_STAGE(PG8_SB(1, 1), b3 + hstep, voffB);
            PG8_WAIT_V(6); PG8_BAR; PG8_MMA(1, 1, At, B1); PG8_BAR;
        }
        E(acc, cur, wr, wc, fr, fq);
        if (!has_next) break;
        if (!E.keep_acc(cur))
#pragma unroll
        for (int a = 0; a < 2; ++a)
#pragma unroll
            for (int b = 0; b < 2; ++b)
#pragma unroll
                for (int m = 0; m < 4; ++m)
#pragma unroll
                    for (int n = 0; n < 2; ++n) acc[a][b][m][n] = (f32x4){0.f, 0.f, 0.f, 0.f};
        cur = nxt; cA = nA; cB = nB; ++ui;
    }
    PG8_WAIT_V(0);
    if (wr == 0) PG8_BAR;
    PG8_BAR;
#undef PG8_SA
#undef PG8_SB
#undef PG8_STAGE
#undef PG8_LDA
#undef PG8_LDB
#undef PG8_MMA
#undef PG8_WAIT_V
#undef PG8_WAIT_L
#undef PG8_BAR
#undef PG8_SCHED
}
}
using pg8::Unit;

typedef f32x4 Acc[2][2][4][2];
__device__ __forceinline__ u32x4 pack8(f32x4 a, f32x4 b) { u32x4 w; w.x = pk2(a[0], a[1]); w.y = pk2(a[2], a[3]); w.z = pk2(b[0], b[1]); w.w = pk2(b[2], b[3]); return w; }
__device__ __forceinline__ float sq8(f32x4 a, f32x4 b) { return (a[0] * a[0] + a[1] * a[1]) + (a[2] * a[2] + a[3] * a[3]) + (b[0] * b[0] + b[1] * b[1]) + (b[2] * b[2] + b[3] * b[3]); }
__device__ __forceinline__ float red_fq(float s) { s += __shfl_xor(s, 16); s += __shfl_xor(s, 32); return s; }

template <int PH> struct Epi {
    Params P;
    __device__ __forceinline__ bool keep_acc(const Unit& u) const { return PH == 5 && u.g == 0; }
    __device__ __forceinline__ void operator()(Acc& acc, const Unit& u, int wr, int wc, int fr, int fq) const {
        unsigned char* ws = P.ws;
        const int row0 = u.pm * 256 + wr * 64 + fr;
        const int cl0 = wc * 32 + 8 * fq;
        if constexpr (PH == 1) {
            const int pn = u.pn;
            if (pn < 2) {
                bf16_t* O = (bf16_t*)(ws + R_C); float* ssq = (float*)(ws + W_SSQ_CQ);
#pragma unroll
                for (int ai = 0; ai < 2; ++ai)
#pragma unroll
                    for (int m = 0; m < 4; ++m) { const int R = row0 + ai * 128 + m * 16; float s = 0.f;
#pragma unroll
                        for (int bj = 0; bj < 2; ++bj) { *(u32x4*)(O + (size_t)R * 512 + pn * 256 + bj * 128 + cl0) = pack8(acc[ai][bj][m][0], acc[ai][bj][m][1]); s += sq8(acc[ai][bj][m][0], acc[ai][bj][m][1]); }
                        s = red_fq(s); if (fq == 0) unsafeAtomicAdd(ssq + R, s); }
            } else if (pn < 4) {
                bf16_t* O = (bf16_t*)(ws + R_D); float* ssq = (float*)(ws + W_SSQ_CKV);
#pragma unroll
                for (int ai = 0; ai < 2; ++ai)
#pragma unroll
                    for (int m = 0; m < 4; ++m) { const int R = row0 + ai * 128 + m * 16; float s = 0.f;
#pragma unroll
                        for (int bj = 0; bj < 2; ++bj) { *(u32x4*)(O + (size_t)R * 512 + (pn - 2) * 256 + bj * 128 + cl0) = pack8(acc[ai][bj][m][0], acc[ai][bj][m][1]); s += sq8(acc[ai][bj][m][0], acc[ai][bj][m][1]); }
                        s = red_fq(s); if (fq == 0) unsafeAtomicAdd(ssq + R, s); }
            } else if (pn < 8) {
                bf16_t* O = (bf16_t*)(ws + R_B);
#pragma unroll
                for (int ai = 0; ai < 2; ++ai)
#pragma unroll
                    for (int m = 0; m < 4; ++m) { const int R = row0 + ai * 128 + m * 16;
#pragma unroll
                        for (int bj = 0; bj < 2; ++bj) *(u32x4*)(O + (size_t)R * 1024 + (pn - 4) * 256 + bj * 128 + cl0) = pack8(acc[ai][bj][m][0], acc[ai][bj][m][1]); }
            } else if (pn < 16) {
                const int which = (pn - 8) >> 2, ct = (pn - 8) & 3;
                bf16_t* O = u.pm < 256 ? (bf16_t*)P.out + (size_t)which * MP * 1024 : (bf16_t*)(ws + W_GS) + (size_t)which * 256 * 1024 - (size_t)MP * 1024;
#pragma unroll
                for (int ai = 0; ai < 2; ++ai)
#pragma unroll
                    for (int m = 0; m < 4; ++m) { const int R = row0 + ai * 128 + m * 16;
#pragma unroll
                        for (int bj = 0; bj < 2; ++bj) { f32x4 a = acc[ai][bj][m][0], b = acc[ai][bj][m][1];
#pragma unroll
                            for (int j = 0; j < 4; ++j) { a[j] = sigmoidf_(a[j]); b[j] = sigmoidf_(b[j]); }
                            *(u32x4*)(O + (size_t)R * 1024 + ct * 256 + bj * 128 + cl0) = pack8(a, b); } }
            } else {
                if (wc < 2) {
#pragma unroll
                    for (int ai = 0; ai < 2; ++ai)
#pragma unroll
                        for (int m = 0; m < 4; ++m) { const int R = row0 + ai * 128 + m * 16;
                            if (R < MP + MS) { float* d = (R < MP ? P.out + O_KRP + (size_t)R * 64 : P.out + O_KRS + (size_t)(R - MP) * 64) + cl0; *(f32x4*)d = acc[ai][0][m][0]; *(f32x4*)(d + 4) = acc[ai][0][m][1]; } }
                }
            }
        } else if constexpr (PH == 3) {
            if (u.g == 0) {
                bf16_t* Q = (bf16_t*)(ws + R_A); float* ssq = (float*)(ws + W_SSQ_Q); const float* ssq_cq = (const float*)(ws + W_SSQ_CQ);
                const f32x4* cs = (const f32x4*)(ws + W_CS);
                int c8[2], hd[2], i0[2]; bool rope[2]; f32x4 g0[2], g1[2];
#pragma unroll
                for (int bj = 0; bj < 2; ++bj) { c8[bj] = u.pn * 256 + bj * 128 + cl0; hd[bj] = c8[bj] / 192; const int cin = c8[bj] - hd[bj] * 192; rope[bj] = __builtin_amdgcn_readfirstlane(cin >= 128 ? 1 : 0) != 0; i0[bj] = (cin - 128) >> 1;
                    if (rope[bj]) { g0[bj] = *(const f32x4*)(P.qk_q_g + 128 + i0[bj]); g1[bj] = *(const f32x4*)(P.qk_q_g + 160 + i0[bj]); }
                    else { g0[bj] = *(const f32x4*)(P.qk_q_g + cin); g1[bj] = *(const f32x4*)(P.qk_q_g + cin + 4); } }
#pragma unroll
                for (int ai = 0; ai < 2; ++ai) {
                    float rsv[4]; f32x4 csa[4], csb[4];
#pragma unroll
                    for (int m = 0; m < 4; ++m) { const int R = row0 + ai * 128 + m * 16; rsv[m] = ssq_cq[R];
                        const int pos = tok_pos(R < MP + MS ? R : 0);
                        if (rope[0] || rope[1]) { const int ir = rope[0] ? i0[0] : i0[1]; csa[m] = cs[(pos * 32 + ir) >> 1]; csb[m] = cs[((pos * 32 + ir) >> 1) + 1]; } }
#pragma unroll
                    for (int m = 0; m < 4; ++m) { const int R = row0 + ai * 128 + m * 16;
                        const float rs = __builtin_amdgcn_rsqf(rsv[m] * (1.0f / 512.0f) + EPS);
#pragma unroll
                        for (int bj = 0; bj < 2; ++bj) { const f32x4 a = acc[ai][bj][m][0] * rs, b = acc[ai][bj][m][1] * rs;
                            const float s = red_fq(sq8(a, b)); if (fq == 0) unsafeAtomicAdd(ssq + (size_t)R * 8 + hd[bj], s);
                            u32x4 o;
                            if (!rope[bj]) o = pack8(a * g0[bj], b * g1[bj]);
                            else { const f32x4 ga = g0[bj], gb = g1[bj], cs0 = csa[m], cs1 = csb[m]; f32x4 o0, o1;
                                { const float x1 = a[0] * ga[0], x2 = a[1] * gb[0]; o0[0] = x1 * cs0[0] - x2 * cs0[1]; o0[1] = x1 * cs0[1] + x2 * cs0[0]; }
                                { const float x1 = a[2] * ga[1], x2 = a[3] * gb[1]; o0[2] = x1 * cs0[2] - x2 * cs0[3]; o0[3] = x1 * cs0[3] + x2 * cs0[2]; }
                                { const float x1 = b[0] * ga[2], x2 = b[1] * gb[2]; o1[0] = x1 * cs1[0] - x2 * cs1[1]; o1[1] = x1 * cs1[1] + x2 * cs1[0]; }
                                { const float x1 = b[2] * ga[3], x2 = b[3] * gb[3]; o1[2] = x1 * cs1[2] - x2 * cs1[3]; o1[3] = x1 * cs1[3] + x2 * cs1[2]; }
                                o = pack8(o0, o1); }
                            *(u32x4*)(Q + (size_t)R * 1536 + c8[bj]) = o; } } }
            } else if (u.g == 1) {
                bf16_t* O = (bf16_t*)(ws + R_F); float* ssq = (float*)(ws + W_SSQ_K);
                const f32x4 g0 = *(const f32x4*)(P.qk_k_g + cl0), g1 = *(const f32x4*)(P.qk_k_g + cl0 + 4);
#pragma unroll
                for (int ai = 0; ai < 2; ++ai)
#pragma unroll
                    for (int m = 0; m < 4; ++m) { const int R = row0 + ai * 128 + m * 16;
#pragma unroll
                        for (int bj = 0; bj < 2; ++bj) { const f32x4 a = acc[ai][bj][m][0], b = acc[ai][bj][m][1];
                            float s = red_fq(sq8(a, b)); if (fq == 0) unsafeAtomicAdd(ssq + (size_t)R * 8 + u.pn * 2 + bj, s);
                            *(u32x4*)(O + (size_t)R * 1024 + u.pn * 256 + bj * 128 + cl0) = pack8(a * g0, b * g1); } }
            } else {
                bf16_t* O = (bf16_t*)(ws + R_G);
#pragma unroll
                for (int ai = 0; ai < 2; ++ai)
#pragma unroll
                    for (int m = 0; m < 4; ++m) { const int R = row0 + ai * 128 + m * 16;
#pragma unroll
                        for (int bj = 0; bj < 2; ++bj) {
                            const int c8 = u.pn * 256 + bj * 128 + cl0, hf = (c8 >> 3) & 1; bf16_t* o = O + (size_t)R * MKV + (c8 & ~15) + 4 * hf;
                            const f32x4 a = acc[ai][bj][m][0], b = acc[ai][bj][m][1];
                            *(u32x2*)o = (u32x2){pk2(a[0], a[1]), pk2(a[2], a[3])}; *(u32x2*)(o + 8) = (u32x2){pk2(b[0], b[1]), pk2(b[2], b[3])}; } }
            }
        } else if constexpr (PH == 5) {
            bf16_t* O = (bf16_t*)(ws + R_C);
            const bf16_t* G0 = u.pm < 256 ? (const bf16_t*)P.out : (const bf16_t*)(ws + W_GS) - (size_t)MP * 1024;
            const bf16_t* G1 = u.pm < 256 ? (const bf16_t*)P.out + (size_t)MP * 1024 : (const bf16_t*)(ws + W_GS) + (size_t)256 * 1024 - (size_t)MP * 1024;
#pragma unroll
            for (int ai = 0; ai < 2; ++ai) {
                u32x4 ga[4][2], gb[4][2];
#pragma unroll
                for (int m = 0; m < 4; ++m)
#pragma unroll
                    for (int bj = 0; bj < 2; ++bj) { const size_t o = (size_t)(row0 + ai * 128 + m * 16) * 1024 + u.pn * 256 + bj * 128 + cl0; gb[m][bj] = *(const u32x4*)(G1 + o); if (u.g == 0) ga[m][bj] = *(const u32x4*)(G0 + o); }
#pragma unroll
                for (int m = 0; m < 4; ++m)
#pragma unroll
                    for (int bj = 0; bj < 2; ++bj) { const size_t o = (size_t)(row0 + ai * 128 + m * 16) * 1024 + u.pn * 256 + bj * 128 + cl0;
                        const u32x4 b4 = gb[m][bj];
                        float fb[8] = {bflo(b4.x), bfhi(b4.x), bflo(b4.y), bfhi(b4.y), bflo(b4.z), bfhi(b4.z), bflo(b4.w), bfhi(b4.w)};
                        if (u.g == 0) { const u32x4 a4 = ga[m][bj];
                            const float fa[8] = {bflo(a4.x), bfhi(a4.x), bflo(a4.y), bfhi(a4.y), bflo(a4.z), bfhi(a4.z), bflo(a4.w), bfhi(a4.w)};
#pragma unroll
                            for (int j = 0; j < 4; ++j) { acc[ai][bj][m][0][j] *= fa[j] * __builtin_amdgcn_rcpf(fmaxf(fb[j], 1e-20f)); acc[ai][bj][m][1][j] *= fa[4 + j] * __builtin_amdgcn_rcpf(fmaxf(fb[4 + j], 1e-20f)); }
                        } else { f32x4 a = acc[ai][bj][m][0], b = acc[ai][bj][m][1];
#pragma unroll
                            for (int j = 0; j < 4; ++j) { a[j] *= fb[j]; b[j] *= fb[4 + j]; }
                            *(u32x4*)(O + o) = pack8(a, b); } } }
        } else if constexpr (PH == 6) {
            bf16_t* O = (bf16_t*)(ws + R_E); float* ssq = (float*)(ws + W_SSQ2);
#pragma unroll
            for (int ai = 0; ai < 2; ++ai) {
                f32x4 xv[4][2][2];
#pragma unroll
                for (int m = 0; m < 4; ++m) { const int R = row0 + ai * 128 + m * 16; const int Rc = R < MP + MS ? R : 0;
                    const float* xs = Rc < MP ? P.x_p + (size_t)Rc * 1024 : P.x_s + (size_t)(Rc - MP) * 1024;
#pragma unroll
                    for (int bj = 0; bj < 2; ++bj) { const int c = u.pn * 256 + bj * 128 + cl0; xv[m][bj][0] = *(const f32x4*)(xs + c); xv[m][bj][1] = *(const f32x4*)(xs + c + 4); } }
#pragma unroll
                for (int m = 0; m < 4; ++m) { const int R = row0 + ai * 128 + m * 16; float s = 0.f;
                    const bool valid = R < MP + MS;
#pragma unroll
                    for (int bj = 0; bj < 2; ++bj) { const int c = u.pn * 256 + bj * 128 + cl0;
                        f32x4 a = acc[ai][bj][m][0], b = acc[ai][bj][m][1];
                        if (valid) { a += xv[m][bj][0]; b += xv[m][bj][1]; }
                        else { a = (f32x4){0.f, 0.f, 0.f, 0.f}; b = a; }
                        s += sq8(a, b);
                        *(u32x4*)(O + (size_t)R * 1024 + c) = pack8(a, b); }
                    s = red_fq(s); if (fq == 0) unsafeAtomicAdd(ssq + R, s); } }
        } else if constexpr (PH == 7) {
            bf16_t* O = (bf16_t*)(ws + R_A); const float* ssq = (const float*)(ws + W_SSQ2);
            float rsv[2][4];
#pragma unroll
            for (int ai = 0; ai < 2; ++ai)
#pragma unroll
                for (int m = 0; m < 4; ++m) rsv[ai][m] = ssq[row0 + ai * 128 + m * 16];
#pragma unroll
            for (int ai = 0; ai < 2; ++ai)
#pragma unroll
                for (int m = 0; m < 4; ++m) { const int R = row0 + ai * 128 + m * 16;
                    const float rs = __builtin_amdgcn_rsqf(rsv[ai][m] * (1.0f / 1024.0f) + EPS);
                    f32x4 o[2];
#pragma unroll
                    for (int n = 0; n < 2; ++n)
#pragma unroll
                        for (int j = 0; j < 4; ++j) { const float g = acc[ai][0][m][n][j] * rs, up = acc[ai][1][m][n][j] * rs; o[n][j] = g * sigmoidf_(g) * up; }
                    *(u32x4*)(O + (size_t)R * DFF + u.pn * 128 + cl0) = pack8(o[0], o[1]); }
        } else if constexpr (PH == 8) {
            const bf16_t* X1 = (const bf16_t*)(ws + R_E);
#pragma unroll
            for (int ai = 0; ai < 2; ++ai) {
                u32x4 xv[4][2];
#pragma unroll
                for (int m = 0; m < 4; ++m)
#pragma unroll
                    for (int bj = 0; bj < 2; ++bj) xv[m][bj] = *(const u32x4*)(X1 + (size_t)(row0 + ai * 128 + m * 16) * 1024 + u.pn * 256 + bj * 128 + cl0);
#pragma unroll
                for (int m = 0; m < 4; ++m) { const int R = row0 + ai * 128 + m * 16;
                    if (R < MP + MS) { float* ys = R < MP ? P.out + O_YP + (size_t)R * 1024 : P.out + O_YS + (size_t)(R - MP) * 1024;
#pragma unroll
                        for (int bj = 0; bj < 2; ++bj) { float* y = ys + u.pn * 256 + bj * 128 + cl0; const u32x4 v = xv[m][bj];
                            *(f32x4*)y = (f32x4){bflo(v.x), bfhi(v.x), bflo(v.y), bfhi(v.y)} + acc[ai][bj][m][0]; *(f32x4*)(y + 4) = (f32x4){bflo(v.z), bfhi(v.z), bflo(v.w), bfhi(v.w)} + acc[ai][bj][m][1]; } } } }
        }
    }
};

template <class DstFn>
__device__ __forceinline__ void tp_matrix(const float* W, int K, int N, const float* ks, bf16_t* Wt, int ldt, DstFn dst, LAS float* scr, int gw, int ngw, int lane, int& off) {
    const int nblk = N / 32, nitems = (K / 64) * nblk;
    int start = (gw - off) % ngw; if (start < 0) start += ngw;
    off = (off + nitems) % ngw;
    for (int it = start; it < nitems; it += ngw) {
        const int k0 = 64 * (it / nblk), n0 = 32 * (it % nblk);
        const int c4 = lane & 7, kr = lane >> 3;
        f32x4 v[8];
#pragma unroll
        for (int i = 0; i < 8; ++i) v[i] = *(const f32x4*)(W + (size_t)(k0 + kr + 8 * i) * N + n0 + 4 * c4);
#pragma unroll
        for (int i = 0; i < 8; ++i) { const int kk = kr + 8 * i; const float sc = ks ? ks[k0 + kk] : 1.0f;
#pragma unroll
            for (int e = 0; e < 4; ++e) scr[kk * 33 + 4 * c4 + e] = v[i][e] * sc; }
        LDS_WAIT();
        const int c = lane & 7;
#pragma unroll
        for (int j = 0; j < 4; ++j) { const int n = (lane >> 3) + 8 * j; const LAS float* s = scr + (8 * c) * 33 + n;
            u32x4 o; o.x = pk2(s[0 * 33], s[1 * 33]); o.y = pk2(s[2 * 33], s[3 * 33]); o.z = pk2(s[4 * 33], s[5 * 33]); o.w = pk2(s[6 * 33], s[7 * 33]);
            const int dr = dst(n0 + n);
            *(u32x4*)(Wt + (size_t)dr * ldt + k0 + 8 * c) = o; }
        LDS_WAIT();
    }
}
template <bool TABLE>
__device__ __forceinline__ void kr_row(const Params& P, const float* raw, int pos, bf16_t* dst, float* ssq, int i) {
    const float x1 = raw[i], x2 = raw[32 + i];
    float s = x1 * x1 + x2 * x2;
#pragma unroll
    for (int o = 1; o < 32; o <<= 1) s += __shfl_xor(s, o);
    const f32x2 cs = TABLE ? ((const f32x2*)(P.ws + W_CS))[pos * 32 + i] : rope_cs(pos, i);
    const float a = x1 * P.qk_k_g[128 + i], b = x2 * P.qk_k_g[160 + i];
    ((unsigned*)dst)[i] = pk2(a * cs.x - b * cs.y, a * cs.y + b * cs.x);
    if (i == 0) *ssq = s;
}
__device__ __forceinline__ void phase0(const Params& P, LAS unsigned char* lds) {
    unsigned char* ws = P.ws;
    const int tid = my_tid(), lane = tid & 63, wave = tid >> 6;
    const int gw = blockIdx.x * 8 + wave, ngw = gridDim.x * 8;
    const size_t gt = (size_t)blockIdx.x * 512 + tid, ngt = (size_t)gridDim.x * 512;
    LAS float* scr = (LAS float*)(lds + wave * 16384);
    for (size_t i = gt; i < (W_SSQ_END - W_SSQ0) / 16; i += ngt) ((u32x4*)(ws + W_SSQ0))[i] = (u32x4){0u, 0u, 0u, 0u};
    for (size_t i = gt; i < (size_t)192 * 1024 * 2 / 16; i += ngt) ((u32x4*)(ws + W_IN + (size_t)(16 * 256 + 64) * 1024 * 2))[i] = (u32x4){0u, 0u, 0u, 0u};
    for (size_t i = gt; i < (size_t)4096 * 32; i += ngt) ((f32x2*)(ws + W_CS))[i] = rope_cs((int)(i >> 5), (int)(i & 31));
    int toff = 0;
    tp_matrix(P.w_in, 1024, 4160, nullptr, (bf16_t*)(ws + W_IN), 1024, [](int n) { return n < 1024 ? n : (n < 1088 ? 4096 + (n - 1024) : n - 1088 + 1024); }, scr, gw, ngw, lane, toff);
    tp_matrix(P.w_uq, 512, 1536, P.q_norm_g, (bf16_t*)(ws + W_UQ), 512, [](int n) { const int h = n / 192, j = n % 192; return h * 192 + (j < 128 ? j : (j < 160 ? 128 + 2 * (j - 128) : 129 + 2 * (j - 160))); }, scr, gw, ngw, lane, toff);
    tp_matrix(P.w_ukv, 512, 2048, nullptr, (bf16_t*)(ws + W_UK), 512, [](int n) { const int h = n >> 8, j = n & 255; return j < 128 ? h * 128 + j : 1024 + h * 128 + (j - 128); }, scr, gw, ngw, lane, toff);
    tp_matrix(P.w_pa, 1024, 1024, nullptr, (bf16_t*)(ws + W_PA), 1024, [](int n) { return n; }, scr, gw, ngw, lane, toff);
    tp_matrix(P.w_pr, 1024, 1024, nullptr, (bf16_t*)(ws + W_PR), 1024, [](int n) { return n; }, scr, gw, ngw, lane, toff);
    tp_matrix(P.w_out, 1024, 1024, nullptr, (bf16_t*)(ws + W_OUT), 1024, [](int n) { return n; }, scr, gw, ngw, lane, toff);
    tp_matrix(P.w_fg, 1024, DFF, P.norm2_g, (bf16_t*)(ws + W_GU), 1024, [](int n) { return (n >> 7) * 256 + (n & 127); }, scr, gw, ngw, lane, toff);
    tp_matrix(P.w_fu, 1024, DFF, P.norm2_g, (bf16_t*)(ws + W_GU), 1024, [](int n) { return (n >> 7) * 256 + 128 + (n & 127); }, scr, gw, ngw, lane, toff);
    tp_matrix(P.w_fd, DFF, 1024, nullptr, (bf16_t*)(ws + W_D), DFF, [](int n) { return n; }, scr, gw, ngw, lane, toff);
    for (int b = 0; b < 8; ++b) {
        tp_matrix(P.w_rg_a + b * 16384, 128, 128, nullptr, (bf16_t*)(ws + W_RA) + b * 16384, 128, [](int n) { return n; }, scr, gw, ngw, lane, toff);
        tp_matrix(P.w_rg_x + b * 16384, 128, 128, nullptr, (bf16_t*)(ws + W_RX) + b * 16384, 128, [](int n) { return n; }, scr, gw, ngw, lane, toff);
    }
    { f32x4 g1[4];
#pragma unroll
      for (int j = 0; j < 4; ++j) g1[j] = ((const f32x4*)P.norm1_g)[lane + 64 * j];
      for (int R0 = gw; R0 < MT; R0 += 4 * ngw) {
        f32x4 v[4][4];
#pragma unroll
        for (int u = 0; u < 4; ++u) { const int R = R0 + u * ngw; const int Rc = R < MP + MS ? R : 0;
            const f32x4* xr = (const f32x4*)(Rc < MP ? P.x_p + (size_t)Rc * 1024 : P.x_s + (size_t)(Rc - MP) * 1024) + lane;
#pragma unroll
            for (int j = 0; j < 4; ++j) v[u][j] = xr[64 * j]; }
#pragma unroll
        for (int u = 0; u < 4; ++u) { const int R = R0 + u * ngw;
            if (R < MT) { u32x2* o = (u32x2*)(ws + R_A + (size_t)R * 2048) + lane; float s = 0.f;
#pragma unroll
                for (int j = 0; j < 4; ++j) s += (v[u][j].x * v[u][j].x + v[u][j].y * v[u][j].y) + (v[u][j].z * v[u][j].z + v[u][j].w * v[u][j].w);
                const float rs = R < MP + MS ? __builtin_amdgcn_rsqf(wave_sum(s) * (1.0f / 1024.0f) + EPS) : 0.f;
#pragma unroll
                for (int j = 0; j < 4; ++j) { const f32x4 g = g1[j] * rs; u32x2 w; w.x = pk2(v[u][j].x * g.x, v[u][j].y * g.y); w.y = pk2(v[u][j].z * g.z, v[u][j].w * g.w); o[64 * j] = w; } } }
      } }
    for (size_t i = gt; i < (size_t)SB * PAST * 512 / 8; i += ngt) { const f32x4 a = ((const f32x4*)P.cache_ckv)[2 * i], b = ((const f32x4*)P.cache_ckv)[2 * i + 1];
        ((u32x4*)(ws + R_D + (size_t)R_PAST0 * 512 * 2))[i] = pack8(a, b); }
    for (size_t i = gt; i < (size_t)SB * PAST * 32; i += ngt) { const int idx = (int)(i >> 5); kr_row<false>(P, P.cache_kr + (size_t)idx * 64, idx & (PAST - 1), (bf16_t*)(ws + W_KR) + (size_t)(R_PAST0 + idx) * 64, (float*)(ws + W_SSQ_KR) + R_PAST0 + idx, (int)(i & 31)); }
}

__device__ __forceinline__ f32x16 mfma32(bf16x8 a, bf16x8 b, f32x16 c) { return __builtin_amdgcn_mfma_f32_32x32x16_bf16(a, b, c, 0, 0, 0); }

constexpr int XC_PITCH = 272, WG_PITCH = 272;
constexpr int L_XC = 0, L_WA = L_XC + 256 * XC_PITCH, L_WX = L_WA + 64 * WG_PITCH, L_AGG = L_WX + 64 * WG_PITCH;

__device__ __forceinline__ void rnn_chain(const Params& P, LAS unsigned char* lds, int Rbase, int ntiles, int nvalid, int n, int jh, const float* hist, const float* h0, float* hlast) {
    unsigned char* ws = P.ws;
    const int tid = my_tid(), lane = tid & 63, w = tid >> 6, r = lane & 31, hh = lane >> 5;
    const bf16_t* Xr = (const bf16_t*)(ws + R_B); bf16_t* Hs = (bf16_t*)(ws + R_E);
    __syncthreads();
    for (int i = tid; i < 64 * 16; i += 512) { const int j = i >> 4, c = i & 15;
        *(LAS u32x4*)(lds + L_WA + j * WG_PITCH + c * 16) = *(const u32x4*)((const bf16_t*)(ws + W_RA) + (size_t)n * 16384 + (jh * 64 + j) * 128 + c * 8);
        *(LAS u32x4*)(lds + L_WX + j * WG_PITCH + c * 16) = *(const u32x4*)((const bf16_t*)(ws + W_RX) + (size_t)n * 16384 + (jh * 64 + j) * 128 + c * 8); }
    const int c16 = tid & 15, run = tid >> 4, ch0 = n * 128 + c16 * 8;
    float cw[4][8], cb[8];
#pragma unroll
    for (int j = 0; j < 4; ++j) { const f32x4 a = *(const f32x4*)(P.conv_w + j * 1024 + ch0), b = *(const f32x4*)(P.conv_w + j * 1024 + ch0 + 4);
#pragma unroll
        for (int e = 0; e < 4; ++e) { cw[j][e] = a[e]; cw[j][4 + e] = b[e]; } }
    { const f32x4 a = *(const f32x4*)(P.conv_b + ch0), b = *(const f32x4*)(P.conv_b + ch0 + 4);
#pragma unroll
        for (int e = 0; e < 4; ++e) { cb[e] = a[e]; cb[4 + e] = b[e]; } }
    float ba[2], bx[2], sp[2], carry[2];
#pragma unroll
    for (int ct = 0; ct < 2; ++ct) { const int ch = n * 128 + jh * 64 + ct * 32 + r; ba[ct] = P.b_rg_a[ch]; bx[ct] = P.b_rg_x[ch]; sp[ct] = -8.0f * 1.4426950408889634f * log1pf(expf(-P.lam[ch])); carry[ct] = h0 ? h0[ch] : 0.f; }
    u32x4 xr[11];
#pragma unroll
    for (int k = 0; k < 11; ++k) { const int t = run * 8 - 3 + k; xr[k] = *(const u32x4*)(Xr + (size_t)(Rbase + (t < 0 ? 0 : t)) * 1024 + ch0); }
    for (int tile = 0; tile < ntiles; ++tile) {
        const int R0 = Rbase + tile * 256;
        {
            float xw[3][8];
#pragma unroll
            for (int k = 0; k < 3; ++k) { const int t = tile * 256 + run * 8 - 3 + k;
                if (t >= 0) { const u32x4 v = xr[k];
                    xw[k][0] = bflo(v.x); xw[k][1] = bfhi(v.x); xw[k][2] = bflo(v.y); xw[k][3] = bfhi(v.y); xw[k][4] = bflo(v.z); xw[k][5] = bfhi(v.z); xw[k][6] = bflo(v.w); xw[k][7] = bfhi(v.w); }
                else if (hist) { const f32x4 a = *(const f32x4*)(hist + (3 + t) * 1024 + ch0), b = *(const f32x4*)(hist + (3 + t) * 1024 + ch0 + 4);
#pragma unroll
                    for (int e = 0; e < 4; ++e) { xw[k][e] = a[e]; xw[k][4 + e] = b[e]; } }
                else {
#pragma unroll
                    for (int e = 0; e < 8; ++e) xw[k][e] = 0.f; } }
#pragma unroll
            for (int rr = 0; rr < 8; ++rr) {
                const u32x4 v = xr[3 + rr];
                float xc[8]; xc[0] = bflo(v.x); xc[1] = bfhi(v.x); xc[2] = bflo(v.y); xc[3] = bfhi(v.y); xc[4] = bflo(v.z); xc[5] = bfhi(v.z); xc[6] = bflo(v.w); xc[7] = bfhi(v.w);
                float y[8];
#pragma unroll
                for (int e = 0; e < 8; ++e) { y[e] = cb[e] + xw[0][e] * cw[0][e] + xw[1][e] * cw[1][e] + xw[2][e] * cw[2][e] + xc[e] * cw[3][e]; xw[0][e] = xw[1][e]; xw[1][e] = xw[2][e]; xw[2][e] = xc[e]; }
                u32x4 o; o.x = pk2(y[0], y[1]); o.y = pk2(y[2], y[3]); o.z = pk2(y[4], y[5]); o.w = pk2(y[6], y[7]);
                *(LAS u32x4*)(lds + L_XC + (run * 8 + rr) * XC_PITCH + c16 * 16) = o; }
        }
        if (tile + 1 < ntiles) {
#pragma unroll
            for (int k = 0; k < 11; ++k) xr[k] = *(const u32x4*)(Xr + (size_t)(Rbase + (tile + 1) * 256 + run * 8 - 3 + k) * 1024 + ch0); }
        __syncthreads();
        f32x16 aA[2], aX[2];
#pragma unroll
        for (int ct = 0; ct < 2; ++ct)
#pragma unroll
            for (int e = 0; e < 16; ++e) { aA[ct][e] = 0.f; aX[ct][e] = 0.f; }
#pragma unroll
        for (int s = 0; s < 8; ++s) { const bf16x8 a = *(const LAS bf16x8*)(lds + L_XC + (32 * w + r) * XC_PITCH + (16 * s + 8 * hh) * 2);
#pragma unroll
            for (int ct = 0; ct < 2; ++ct) { const bf16x8 b0 = *(const LAS bf16x8*)(lds + L_WA + (ct * 32 + r) * WG_PITCH + (16 * s + 8 * hh) * 2), b1 = *(const LAS bf16x8*)(lds + L_WX + (ct * 32 + r) * WG_PITCH + (16 * s + 8 * hh) * 2);
                aA[ct] = mfma32(a, b0, aA[ct]); aX[ct] = mfma32(a, b1, aX[ct]); } }
        float myc[2];
#pragma unroll
        for (int ct = 0; ct < 2; ++ct) {
            const int cl = jh * 64 + ct * 32 + r;
#pragma unroll
            for (int e = 0; e < 16; ++e) { const int tl = 32 * w + (e & 3) + 8 * (e >> 2) + 4 * hh;
                const float rg = sigmoidf_(aA[ct][e] + ba[ct]), ig = sigmoidf_(aX[ct][e] + bx[ct]);
                float a = __builtin_amdgcn_exp2f(rg * sp[ct]); const float mult = __builtin_amdgcn_sqrtf(fmaxf(1.0f - a * a, 0.f));
                const float xcv = bf1(*(const LAS bf16_t*)(lds + L_XC + tl * XC_PITCH + cl * 2));
                float uu = mult * ig * xcv;
                if (tl >= nvalid) { a = 1.0f; uu = 0.f; }
                aA[ct][e] = a; aX[ct][e] = uu; }
            float Ag[4], Hg[4], pA[4], pH[4];
#pragma unroll
            for (int g = 0; g < 4; ++g) {
#pragma unroll
                for (int i = 1; i < 4; ++i) { aX[ct][4 * g + i] = aA[ct][4 * g + i] * aX[ct][4 * g + i - 1] + aX[ct][4 * g + i]; aA[ct][4 * g + i] = aA[ct][4 * g + i] * aA[ct][4 * g + i - 1]; }
                Ag[g] = aA[ct][4 * g + 3]; Hg[g] = aX[ct][4 * g + 3]; pA[g] = __shfl_xor(Ag[g], 32); pH[g] = __shfl_xor(Hg[g], 32); }
            float s = 0.f, q = 1.f, cg_[4], qg[4];
#pragma unroll
            for (int g = 0; g < 4; ++g) {
                if (hh == 0) { cg_[g] = s; qg[g] = q; s = Ag[g] * s + Hg[g]; q *= Ag[g]; s = pA[g] * s + pH[g]; q *= pA[g]; }
                else { s = pA[g] * s + pH[g]; q *= pA[g]; cg_[g] = s; qg[g] = q; s = Ag[g] * s + Hg[g]; q *= Ag[g]; } }
#pragma unroll
            for (int e = 0; e < 16; ++e) { aX[ct][e] += aA[ct][e] * cg_[e >> 2]; aA[ct][e] *= qg[e >> 2]; }
            if (hh == 0) *(LAS f32x2*)(lds + L_AGG + (w * 64 + ct * 32 + r) * 8) = (f32x2){q, s};
        }
        __syncthreads();
#pragma unroll
        for (int ct = 0; ct < 2; ++ct) { float c = carry[ct]; myc[ct] = c;
#pragma unroll
            for (int w2 = 0; w2 < 8; ++w2) { const f32x2 ag = *(const LAS f32x2*)(lds + L_AGG + (w2 * 64 + ct * 32 + r) * 8); if (w2 == w) myc[ct] = c; c = ag.x * c + ag.y; }
            carry[ct] = c;
            const int ch = n * 128 + jh * 64 + ct * 32 + r;
#pragma unroll
            for (int e = 0; e < 16; ++e) { const int tl = 32 * w + (e & 3) + 8 * (e >> 2) + 4 * hh;
                const float hv = aX[ct][e] + aA[ct][e] * myc[ct];
                if (tl < nvalid) Hs[(size_t)(R0 + tl) * 1024 + ch] = (bf16_t)(pk2(hv, hv) & 0xffffu); } }
    }
    if (w == 0 && hh == 0) {
#pragma unroll
        for (int ct = 0; ct < 2; ++ct) hlast[n * 128 + jh * 64 + ct * 32 + r] = carry[ct];
    }
}

__device__ __forceinline__ void phase2(const Params& P, LAS unsigned char* lds) {
    unsigned char* ws = P.ws;
    const int tid = my_tid(), lane = tid & 63, wave = tid >> 6;
    const int gw = blockIdx.x * 8 + wave, ngw = gridDim.x * 8;
    const size_t gt = (size_t)blockIdx.x * 512 + tid, ngt = (size_t)gridDim.x * 512;
    { f32x4 gk[2]; gk[0] = ((const f32x4*)P.kv_norm_g)[lane]; gk[1] = ((const f32x4*)P.kv_norm_g)[lane + 64];
      for (int R0 = gw; R0 < MT; R0 += 4 * ngw) {
        u32x2 r0[4], r1[4]; float sq[4];
#pragma unroll
        for (int u = 0; u < 4; ++u) { const int R = R0 + u * ngw; const int Rc = R < MT ? R : 0;
            const u32x2* o = (const u32x2*)(ws + R_D + (size_t)Rc * 1024) + lane; r0[u] = o[0]; r1[u] = o[64]; sq[u] = ((const float*)(ws + W_SSQ_CKV))[Rc]; }
#pragma unroll
        for (int u = 0; u < 4; ++u) { const int R = R0 + u * ngw;
            if (R < MT) { u32x2* o = (u32x2*)(ws + R_D + (size_t)R * 1024) + lane;
                if (R < MP + MS) {
                    f32x4* xr = (f32x4*)(R < MP ? P.out + O_CKVP + (size_t)R * 512 : P.out + O_CKVS + (size_t)(R - MP) * 512) + lane;
                    const float rs = __builtin_amdgcn_rsqf(sq[u] * (1.0f / 512.0f) + EPS);
                    f32x4 v0 = (f32x4){bflo(r0[u].x), bfhi(r0[u].x), bflo(r0[u].y), bfhi(r0[u].y)} * rs * gk[0], v1 = (f32x4){bflo(r1[u].x), bfhi(r1[u].x), bflo(r1[u].y), bfhi(r1[u].y)} * rs * gk[1];
                    xr[0] = v0; xr[64] = v1;
                    o[0] = (u32x2){pk2(v0.x, v0.y), pk2(v0.z, v0.w)}; o[64] = (u32x2){pk2(v1.x, v1.y), pk2(v1.z, v1.w)};
                } else { o[0] = (u32x2){0u, 0u}; o[64] = (u32x2){0u, 0u}; } } }
      } }
#pragma unroll 4
    for (size_t i = gt; i < (size_t)MT * 32; i += ngt) { const int R = (int)(i >> 5), j = (int)(i & 31);
        if (R < MP + MS) kr_row<true>(P, R < MP ? P.out + O_KRP + (size_t)R * 64 : P.out + O_KRS + (size_t)(R - MP) * 64, tok_pos(R), (bf16_t*)(ws + W_KR) + (size_t)R * 64, (float*)(ws + W_SSQ_KR) + R, j);
        else { ((unsigned*)(ws + W_KR))[(size_t)R * 32 + j] = 0u; if (j == 0) ((float*)(ws + W_SSQ_KR))[R] = 0.f; } }
    for (size_t i = gt; i < (size_t)(NB + SB) * 3 * 1024; i += ngt) { const int c = (int)(i & 1023), j = (int)((i >> 10) % 3), b = (int)(i / 3072);
        const bf16_t* Xr = (const bf16_t*)(ws + R_B);
        if (b < NB) P.out[O_CONVP + (size_t)b * 3072 + j * 1024 + c] = bf1(Xr[(size_t)(b * SEQ + SEQ - 3 + j) * 1024 + c]);
        else P.out[O_CONVS + (size_t)(b - NB) * 3072 + j * 1024 + c] = bf1(Xr[(size_t)(MP + (b - NB) * ST + ST - 3 + j) * 1024 + c]); }
    for (int it = blockIdx.x; it < 256 + 128; it += gridDim.x) {
        if (it < 256) { const int b = it >> 4, n = (it >> 1) & 7, jh = it & 1; rnn_chain(P, lds, b * SEQ, SEQ / 256, 256, n, jh, nullptr, nullptr, P.out + O_HP + (size_t)b * 1024); }
        else { const int k = it - 256, b = k >> 4, n = (k >> 1) & 7, jh = k & 1; rnn_chain(P, lds, MP + b * ST, 1, ST, n, jh, P.state_conv + (size_t)b * 3072, P.state_h + (size_t)b * 1024, P.out + O_HS + (size_t)b * 1024); }
    }
}

constexpr int KBUF = 64 * 384, VBUF = 128 * 128;
constexpr int L_K0 = 0, L_V0 = 2 * KBUF, L_RKT = L_V0 + 2 * VBUF;

struct AttnStage { unsigned kofs[3], kstr[3], vofs[2]; };
__device__ __forceinline__ void attn_stage_init(AttnStage& st, int h, int tid) {
    const int w = tid >> 6, lane = tid & 63;
#pragma unroll
    for (int i = 0; i < 3; ++i) { const int q = (w * 3 + i) * 64 + lane, key = q / 24, slot = q % 24, p = slot ^ ((key >> 1) & 7);
        st.kstr[i] = p >= 16 ? 128u : 2048u;
        st.kofs[i] = p >= 16 ? (unsigned)(W_KR + key * 128 + (p - 16) * 16) : (unsigned)(R_F + key * 2048 + h * 256 + p * 16); }
#pragma unroll
    for (int i = 0; i < 2; ++i) { const int q = (w * 2 + i) * 64 + lane, d = q >> 3, slot = q & 7, p = slot ^ ((d >> 1) & 7);
        st.vofs[i] = (unsigned)R_G + (unsigned)(h * 128 + d) * (unsigned)(MKV * 2) + p * 16; }
}
__device__ __forceinline__ void attn_stage_issue(const Params& P, LAS unsigned char* lds, const AttnStage& st, int R0, int buf, int tid) {
    const char* ws = (const char*)P.ws; const int w = __builtin_amdgcn_readfirstlane(tid >> 6);
#pragma unroll
    for (int i = 0; i < 3; ++i) __builtin_amdgcn_global_load_lds((const unsigned*)(ws + (st.kofs[i] + (unsigned)R0 * st.kstr[i])), (LAS unsigned*)(lds + L_K0 + buf * KBUF + (w * 3 + i) * 1024), 16, 0, 0);
#pragma unroll
    for (int i = 0; i < 2; ++i) __builtin_amdgcn_global_load_lds((const unsigned*)(ws + (st.vofs[i] + (unsigned)R0 * 2u)), (LAS unsigned*)(lds + L_V0 + buf * VBUF + (w * 2 + i) * 1024), 16, 0, 0);
}
__device__ __forceinline__ u32x4 scale8(u32x4 v, float s) { u32x4 o; o.x = pk2(bflo(v.x) * s, bfhi(v.x) * s); o.y = pk2(bflo(v.y) * s, bfhi(v.y) * s); o.z = pk2(bflo(v.z) * s, bfhi(v.z) * s); o.w = pk2(bflo(v.w) * s, bfhi(v.w) * s); return o; }
template <bool NOMAX>
__device__ __forceinline__ void attn_block(const Params& P, LAS unsigned char* lds, int qR0, int h, int kR0, int kR1, int ntiles, int jmax, int nlast, int qvalid) {
    unsigned char* ws = P.ws;
    const int tid = my_tid(), lane = tid & 63, w = tid >> 6, r = lane & 31, hh = lane >> 5, x = (r >> 1) & 7;
    const int qR = qR0 + 32 * w + r;
    AttnStage st; attn_stage_init(st, h, tid);
    attn_stage_issue(P, lds, st, kR0, 0, tid);
    int oc[4];
#pragma unroll
    for (int c4 = 0; c4 < 4; ++c4) oc[c4] = ((2 * c4 + hh) ^ x) << 4;
    bf16x8 qf[12];
    { const float qs = QSCALE * __builtin_amdgcn_rsqf(((const float*)(ws + W_SSQ_Q))[(size_t)qR * 8 + h] * (1.0f / 192.0f) + EPS);
        const bf16_t* q = (const bf16_t*)(ws + R_A) + (size_t)qR * 1536 + h * 192 + 8 * hh;
#pragma unroll
        for (int s = 0; s < 12; ++s) { const u32x4 v = scale8(*(const u32x4*)(q + 16 * s), qs); qf[s] = *(const bf16x8*)&v; } }
    f32x16 oacc[4];
#pragma unroll
    for (int dt = 0; dt < 4; ++dt)
#pragma unroll
        for (int e = 0; e < 16; ++e) oacc[dt][e] = 0.f;
    float mrun = -1e30f, lrun = 0.f;
    asm volatile("s_waitcnt vmcnt(0)" ::: "memory");
    __syncthreads();
    for (int j = 0; j < ntiles; ++j) {
        const int buf = j & 1;
        if (j + 1 < ntiles) { const int Rn = (kR1 >= 0 && j + 1 >= 16) ? kR1 : kR0 + 64 * (j + 1);
            attn_stage_issue(P, lds, st, Rn, buf ^ 1, tid); }
        if (j <= jmax) {
            const LAS unsigned char* kb = lds + L_K0 + buf * KBUF + r * 384; const LAS unsigned char* vb = lds + L_V0 + buf * VBUF + r * 128;
            const LAS unsigned char* rkb = lds + L_RKT + j * 256 + 16 * hh;
            f32x16 sacc[2];
#pragma unroll
            for (int kt = 0; kt < 2; ++kt) {
#pragma unroll
                for (int e = 0; e < 16; ++e) sacc[kt][e] = 0.f;
#pragma unroll
                for (int s = 0; s < 12; ++s) { const bf16x8 kf = *(const LAS bf16x8*)(kb + kt * (32 * 384) + (s >> 2) * 128 + oc[s & 3]); sacc[kt] = mfma32(kf, qf[s], sacc[kt]); }
            }
#pragma unroll
            for (int kt = 0; kt < 2; ++kt)
#pragma unroll
                for (int gq = 0; gq < 4; ++gq) { const f32x4 rk4 = *(const LAS f32x4*)(rkb + (32 * kt + 8 * gq) * 4);
#pragma unroll
                    for (int i = 0; i < 4; ++i) sacc[kt][4 * gq + i] *= rk4[i]; }
            if (j == ntiles - 1 && nlast < 64) {
#pragma unroll
                for (int kt = 0; kt < 2; ++kt)
#pragma unroll
                    for (int e = 0; e < 16; ++e) { const int key = 32 * kt + (e & 3) + 8 * (e >> 2) + 4 * hh; if (key >= nlast) sacc[kt][e] = -1e30f; } }
            float mnew = 0.f;
            if constexpr (!NOMAX) {
                float mx = sacc[0][0];
#pragma unroll
                for (int kt = 0; kt < 2; ++kt)
#pragma unroll
                    for (int e = 0; e < 16; ++e) mx = fmaxf(mx, sacc[kt][e]);
                mx = fmaxf(mx, __shfl_xor(mx, 32));
                const float mcand = fmaxf(mrun, mx);
                if (__any(mcand > mrun + 8.0f)) { const float alpha = __builtin_amdgcn_exp2f(mrun - mcand); lrun *= alpha;
#pragma unroll
                    for (int dt = 0; dt < 4; ++dt)
#pragma unroll
                        for (int e = 0; e < 16; ++e) oacc[dt][e] *= alpha;
                    mrun = mcand; }
                mnew = mrun;
            }
            float ps = 0.f;
#pragma unroll
            for (int kt = 0; kt < 2; ++kt)
#pragma unroll
                for (int e = 0; e < 16; ++e) { const float p = __builtin_amdgcn_exp2f(NOMAX ? sacc[kt][e] : sacc[kt][e] - mnew); sacc[kt][e] = p; ps += p; }
            lrun += ps;
            bf16x8 pf[2][2];
#pragma unroll
            for (int kt = 0; kt < 2; ++kt)
#pragma unroll
                for (int s2 = 0; s2 < 2; ++s2) { u32x4 v; v.x = pk2(sacc[kt][8 * s2 + 0], sacc[kt][8 * s2 + 1]); v.y = pk2(sacc[kt][8 * s2 + 2], sacc[kt][8 * s2 + 3]); v.z = pk2(sacc[kt][8 * s2 + 4], sacc[kt][8 * s2 + 5]); v.w = pk2(sacc[kt][8 * s2 + 6], sacc[kt][8 * s2 + 7]); pf[kt][s2] = *(const bf16x8*)&v; }
#pragma unroll
            for (int dt = 0; dt < 4; ++dt)
#pragma unroll
                for (int kt = 0; kt < 2; ++kt)
#pragma unroll
                    for (int s2 = 0; s2 < 2; ++s2) { const bf16x8 vf = *(const LAS bf16x8*)(vb + dt * (32 * 128) + oc[2 * kt + s2]);
                        oacc[dt] = mfma32(vf, pf[kt][s2], oacc[dt]); }
        }
        asm volatile("s_waitcnt vmcnt(0)" ::: "memory");
        __syncthreads();
    }
    if (jmax >= 0) {
        const float l = lrun + __shfl_xor(lrun, 32), inv = __builtin_amdgcn_rcpf(l);
        if (r < qvalid) { bf16_t* o = (bf16_t*)(ws + R_H) + (size_t)qR * 1024 + h * 128 + 4 * hh;
#pragma unroll
            for (int dt = 0; dt < 4; ++dt)
#pragma unroll
                for (int gq = 0; gq < 4; ++gq) { u32x2 v; v.x = pk2(oacc[dt][4 * gq] * inv, oacc[dt][4 * gq + 1] * inv); v.y = pk2(oacc[dt][4 * gq + 2] * inv, oacc[dt][4 * gq + 3] * inv); *(u32x2*)(o + 32 * dt + 8 * gq) = v; } }
    }
}
__device__ __forceinline__ void phase4(const Params& P, LAS unsigned char* lds) {
    const unsigned char* ws = P.ws;
    const int tid = my_tid(), w = tid >> 6;
    const float* sk = (const float*)(ws + W_SSQ_K); const float* skr = (const float*)(ws + W_SSQ_KR);
    bool nomax;
    { const int l = tid & 63; float gq = 0.f, gk = 0.f;
#pragma unroll
      for (int i = 0; i < 3; ++i) { gq = fmaxf(gq, fabsf(P.qk_q_g[l + 64 * i])); gk = fmaxf(gk, fabsf(P.qk_k_g[l + 64 * i])); }
#pragma unroll
      for (int o = 1; o < 64; o <<= 1) { gq = fmaxf(gq, __shfl_xor(gq, o)); gk = fmaxf(gk, __shfl_xor(gk, o)); }
      nomax = __builtin_amdgcn_readfirstlane((192.0f * QSCALE * gq * gk <= 60.0f) ? 1 : 0) != 0; }
    for (int it = blockIdx.x; it < 1024 + 64; it += gridDim.x) {
        if (it < 1024) {
            const int cc = it & 255, kk = it >> 8, bh = ((kk * 4 + (cc >> 6)) << 3) + (cc & 7), i = (cc >> 3) & 7, b = bh >> 3, h = bh & 7;
            for (int key = tid; key < (16 - i) * 256; key += 512) { const int R = b * SEQ + key; *(LAS float*)(lds + L_RKT + key * 4) = __builtin_amdgcn_rsqf((sk[(size_t)R * 8 + h] + skr[R]) * (1.0f / 192.0f) + EPS); }
            __syncthreads();
#pragma unroll 1
            for (int k = 0; k < 2; ++k) { const int blk = k ? i : 15 - i;
                if (nomax) attn_block<true>(P, lds, b * SEQ + blk * 256, h, b * SEQ, -1, 4 * blk + 4, 4 * blk + (w >> 1), 64, 32);
                else attn_block<false>(P, lds, b * SEQ + blk * 256, h, b * SEQ, -1, 4 * blk + 4, 4 * blk + (w >> 1), 64, 32); }
        } else { const int k = it - 1024, b = k >> 3, h = k & 7;
            for (int key = tid; key < 1088; key += 512) { const int R = key < PAST ? R_PAST0 + b * PAST + key : MP + b * ST + (key - PAST); *(LAS float*)(lds + L_RKT + key * 4) = __builtin_amdgcn_rsqf((sk[(size_t)R * 8 + h] + skr[R]) * (1.0f / 192.0f) + EPS); }
            __syncthreads();
            if (nomax) attn_block<true>(P, lds, MP + b * ST, h, R_PAST0 + b * PAST, MP + b * ST, 17, w == 0 ? 16 : -1, ST, ST);
            else attn_block<false>(P, lds, MP + b * ST, h, R_PAST0 + b * PAST, MP + b * ST, 17, w == 0 ? 16 : -1, ST, ST); }
    }
}

#define XB_TMO      128
#define XB_XCNT(j)  (256  + 64 * (j))
#define XB_XSUB(j)  (1280 + 64 * (j))
#define XB_XGEN(j)  (2304 + 64 * (j))
#define XB_TOP      3328
#define XB_TOPGEN   3392
#define XCD_BAR_WORDS 3456
#define XB_SPIN_CAP (1u << 18)
__device__ __forceinline__ unsigned xb_ld(unsigned* p)              { return __hip_atomic_load(p, __ATOMIC_RELAXED, __HIP_MEMORY_SCOPE_AGENT); }
__device__ __forceinline__ unsigned xb_add(unsigned* p, unsigned v) { return __hip_atomic_fetch_add(p, v, __ATOMIC_RELAXED, __HIP_MEMORY_SCOPE_AGENT); }
__device__ __forceinline__ unsigned xb_xcc_id() { return (unsigned)__builtin_amdgcn_s_getreg((3 << 11) | 20) & 0xFu; }
#define XB_SPIN(cond, bar) do { unsigned _sp = 0; while (cond) { __builtin_amdgcn_s_sleep(1); \
    if ((++_sp & 255u) == 0u) { if (xb_ld(&(bar)[XB_TMO])) break; if (_sp > XB_SPIN_CAP) { atomicAdd(&(bar)[XB_TMO], 1u); break; } } } } while (0)
__device__ __forceinline__ void xcd_barrier_complete(unsigned* bar, unsigned x, unsigned& nloc, unsigned& nx) {
    const unsigned G = gridDim.x * gridDim.y * gridDim.z;
    unsigned sum, cnt, mine, sp = 0u;
    for (;;) {
        sum = 0u; cnt = 0u; mine = 0u;
#pragma unroll
        for (unsigned j = 0; j < 16; ++j) { const unsigned c = xb_ld(&bar[XB_XCNT(j)]); sum += c; cnt += (c > 0u) ? 1u : 0u; mine = (j == x) ? c : mine; }
        if (sum == G) break;
        __builtin_amdgcn_s_sleep(1);
        if ((++sp & 255u) == 0u) { if (xb_ld(&bar[XB_TMO])) break; if (sp > XB_SPIN_CAP) { atomicAdd(&bar[XB_TMO], 1u); break; } }
    }
    nloc = mine > 0u ? mine : 1u; nx = cnt > 0u ? cnt : 1u;
}
__device__ __forceinline__ void xcd_barrier(unsigned* bar, volatile LAS unsigned* st) {
    asm volatile("s_waitcnt vmcnt(0)" ::: "memory");
    __syncthreads();
    if (threadIdx.x == 0) {
        const unsigned x = xb_xcc_id();
        __builtin_amdgcn_s_waitcnt(0);
        unsigned nloc = st[0], nx = st[1];
        if (nloc == 0u) { xcd_barrier_complete(bar, x, nloc, nx); st[0] = nloc; st[1] = nx; }
        const unsigned old = xb_add(&bar[XB_XSUB(x)], 1u);
        const unsigned gen = old / nloc;
        if (old + 1u == (gen + 1u) * nloc) {
            __builtin_amdgcn_fence(__ATOMIC_RELEASE, "agent");
            asm volatile("s_waitcnt vmcnt(0)" ::: "memory");
            const unsigned og = xb_add(&bar[XB_TOP], 1u);
            const unsigned tg = og / nx;
            if (og + 1u == (tg + 1u) * nx) xb_add(&bar[XB_TOPGEN], 1u);
            else XB_SPIN(xb_ld(&bar[XB_TOPGEN]) == tg, bar);
            __builtin_amdgcn_fence(__ATOMIC_ACQUIRE, "agent");
            xb_add(&bar[XB_XGEN(x)], 1u);
            asm volatile("s_waitcnt vmcnt(0)" ::: "memory");
        } else {
            XB_SPIN(xb_ld(&bar[XB_XGEN(x)]) == gen, bar);
            __builtin_amdgcn_fence(__ATOMIC_ACQUIRE, "agent");
            asm volatile("s_waitcnt vmcnt(0)" ::: "memory");
        }
    }
    __syncthreads();
}

typedef const __attribute__((address_space(4))) Params* KArgs;
#if defined(__HIP_DEVICE_COMPILE__)
#define LOAD_PARAMS() KArgs kp_ = (KArgs)__builtin_amdgcn_kernarg_segment_ptr(); asm volatile("" : "+s"(kp_)); const Params P = *kp_; unsigned char* ws = P.ws
#else
#define LOAD_PARAMS() const Params P = Pk; unsigned char* ws = P.ws
#endif
__global__ void __launch_bounds__(512, 2) fwd_megakernel(Params Pk) {
    extern __shared__ __attribute__((aligned(16))) unsigned char lds_raw[];
    LAS unsigned char* lds = (LAS unsigned char*)lds_raw;
    cg::grid_group grid = cg::this_grid();
    const int G = gridDim.x, c = blockIdx.x;
    volatile LAS unsigned* xst = (volatile LAS unsigned*)(lds + L_XB);
    if (threadIdx.x == 0) { xst[0] = 0u; xst[1] = 0u; }
    __syncthreads();
    { LOAD_PARAMS(); if (threadIdx.x == 0) (void)xb_add(&((unsigned*)(ws + W_BAR))[XB_XCNT(xb_xcc_id())], 1u); }
#define GRID_BARRIER() do { LOAD_PARAMS(); (void)P; xcd_barrier((unsigned*)(ws + W_BAR), xst); } while (0)
#ifndef PHM
#define PHM 0x1ff
#endif
    grid.sync();
    if (PHM & 1) { LOAD_PARAMS(); (void)ws; phase0(P, lds); }
    GRID_BARRIER();
    if (PHM & 2) { LOAD_PARAMS(); pg8::Order<1, 1, R_A, W_IN, MT / 256, NIN / 256> S{ws, G, c}; Epi<1> E{P}; pg8::gemm_phase(lds, 1024, S, E); }
    GRID_BARRIER();
    if (PHM & 4) { LOAD_PARAMS(); (void)ws; phase2(P, lds); }
    GRID_BARRIER();
    if (PHM & 8) { LOAD_PARAMS(); pg8::Order<3, 1, R_C, W_UQ, MT / 256, 6, R_D, W_UK, MKV / 256, 4, W_UV, R_D, 4, MKV / 256> S{ws, G, c}; Epi<3> E{P}; pg8::gemm_phase(lds, 512, S, E); }
    GRID_BARRIER();
    if (PHM & 16) { LOAD_PARAMS(); (void)ws; phase4(P, lds); }
    GRID_BARRIER();
    if (PHM & 32) { LOAD_PARAMS(); pg8::Order<1, 2, R_H, W_PA, MT / 256, 4, R_E, W_PR> S{ws, G, c}; Epi<5> E{P}; pg8::gemm_phase(lds, 1024, S, E); }
    GRID_BARRIER();
    if (PHM & 64) { LOAD_PARAMS(); pg8::Order<1, 1, R_C, W_OUT, MT / 256, 4> S{ws, G, c}; Epi<6> E{P}; pg8::gemm_phase(lds, 1024, S, E); }
    GRID_BARRIER();
    if (PHM & 128) { LOAD_PARAMS(); pg8::Order<1, 1, R_E, W_GU, MT / 256, 22> S{ws, G, c}; Epi<7> E{P}; pg8::gemm_phase(lds, 1024, S, E); }
    GRID_BARRIER();
    if (PHM & 256) { LOAD_PARAMS(); pg8::Order<1, 1, R_A, W_D, MT / 256, 4> S{ws, G, c}; Epi<8> E{P}; pg8::gemm_phase(lds, DFF, S, E); }
}

extern "C" void kernel_launch(void* const* d_in, const int* in_sizes, int n_in, void* d_out, int out_size, void* d_ws, size_t ws_size, hipStream_t stream) {
    static int grid = 0;
    if (grid == 0) {
        if (n_in != 28 || (size_t)out_size != O_END || ws_size < WS_END) { fprintf(stderr, "kernel_launch: unexpected shapes (n_in %d out %d ws %zu need %zu)\n", n_in, out_size, ws_size, (size_t)WS_END); grid = -1; return; }
        int dev = 0, cus = 0, per_cu = 0;
        hipGetDevice(&dev); hipDeviceGetAttribute(&cus, hipDeviceAttributeMultiprocessorCount, dev);
        if (hipFuncSetAttribute((const void*)fwd_megakernel, hipFuncAttributeMaxDynamicSharedMemorySize, LDS_BYTES) != hipSuccess) { fprintf(stderr, "kernel_launch: hipFuncSetAttribute failed\n"); grid = -1; return; }
        hipOccupancyMaxActiveBlocksPerMultiprocessor(&per_cu, (const void*)fwd_megakernel, 512, LDS_BYTES);
        if (per_cu < 1) { fprintf(stderr, "kernel_launch: occupancy query says %d blocks per CU\n", per_cu); per_cu = 1; }
        (void)hipGetLastError();
        grid = cus;
    }
    if (grid < 0) return;
    Params p{};
    const float** f = (const float**)&p;
    for (int i = 0; i < 28; ++i) f[i] = (const float*)d_in[i];
    p.out = (float*)d_out; p.ws = (unsigned char*)d_ws;
    if (hipMemsetAsync((char*)d_ws + W_BAR, 0, 16384, stream) != hipSuccess) { fprintf(stderr, "kernel_launch: memset of the barrier words failed\n"); return; }
    void* args[] = {&p};
    hipError_t e = hipLaunchCooperativeKernel((const void*)fwd_megakernel, dim3(grid), dim3(512), args, LDS_BYTES, stream);
    if (e != hipSuccess) fprintf(stderr, "cooperative launch failed: %s (grid %d)\n", hipGetErrorString(e), grid);
}
```

```cpp
#include <hip/hip_runtime.h>
#include <hip/hip_cooperative_groups.h>
#include <cstdio>
namespace cg = cooperative_groups;

#define LAS __attribute__((address_space(3)))
typedef unsigned short bf16_t;
typedef short bf16x8 __attribute__((ext_vector_type(8)));
typedef float f32x4 __attribute__((ext_vector_type(4)));
typedef float f32x2 __attribute__((ext_vector_type(2)));
typedef float f32x16 __attribute__((ext_vector_type(16)));
typedef unsigned u32x4 __attribute__((ext_vector_type(4)));
typedef unsigned u32x2 __attribute__((ext_vector_type(2)));

constexpr int DM = 1024, NB = 16, SEQ = 4096, MP = NB * SEQ;
constexpr int SB = 8, ST = 16, MS = SB * ST, PAST = 1024;
constexpr int MT = 65792;
constexpr int MKV = 73984;
constexpr int R_PAST0 = MT;
constexpr int NIN = 4352;
constexpr int DFF = 2816;
constexpr float EPS = 1e-6f;
constexpr float QSCALE = 0.07216878364870322f * 1.4426950408889634f;

constexpr size_t O_YP = 0, O_YS = O_YP + (size_t)MP * DM, O_CKVP = O_YS + (size_t)MS * DM, O_KRP = O_CKVP + (size_t)MP * 512, O_CONVP = O_KRP + (size_t)MP * 64,
                 O_HP = O_CONVP + (size_t)NB * 3 * DM, O_CKVS = O_HP + (size_t)NB * DM, O_KRS = O_CKVS + (size_t)MS * 512, O_CONVS = O_KRS + (size_t)MS * 64,
                 O_HS = O_CONVS + (size_t)SB * 3 * DM, O_END = O_HS + (size_t)SB * DM;

constexpr size_t al256(size_t x) { return (x + 255) & ~(size_t)255; }
constexpr size_t W_IN = 0;
constexpr size_t W_UQ = W_IN + (size_t)NIN * 1024 * 2;
constexpr size_t W_UK = W_UQ + (size_t)2048 * 512 * 2;
constexpr size_t W_UV = W_UK + (size_t)1024 * 512 * 2;
constexpr size_t W_PA = W_UV + (size_t)1024 * 512 * 2;
constexpr size_t W_PR = W_PA + (size_t)1024 * 1024 * 2;
constexpr size_t W_OUT = W_PR + (size_t)1024 * 1024 * 2;
constexpr size_t W_GU = W_OUT + (size_t)1024 * 1024 * 2;
constexpr size_t W_D = W_GU + (size_t)5632 * 1024 * 2;
constexpr size_t W_RA = W_D + (size_t)1024 * DFF * 2;
constexpr size_t W_RX = W_RA + (size_t)8 * 128 * 128 * 2;
constexpr size_t W_CS = W_RX + (size_t)8 * 128 * 128 * 2;
constexpr size_t W_SSQ0 = W_CS + (size_t)4096 * 32 * 8;
constexpr size_t W_SSQ_CQ = W_SSQ0;
constexpr size_t W_SSQ_CKV = W_SSQ_CQ + (size_t)MT * 4;
constexpr size_t W_SSQ_Q = W_SSQ_CKV + (size_t)MT * 4;
constexpr size_t W_SSQ_K = W_SSQ_Q + (size_t)MT * 8 * 4;
constexpr size_t W_SSQ2 = W_SSQ_K + (size_t)MKV * 8 * 4;
constexpr size_t W_SSQ_END = W_SSQ2 + (size_t)MT * 4;
constexpr size_t W_SSQ_KR = W_SSQ_END;
constexpr size_t W_KR = al256(W_SSQ_KR + (size_t)MKV * 4);
constexpr size_t W_GS = al256(W_KR + (size_t)MKV * 64 * 2);
constexpr size_t W_BAR = al256(W_GS + (size_t)2 * 256 * 1024 * 2);
constexpr size_t R_A = al256(W_BAR + 16384);
constexpr size_t R_B = R_A + (size_t)MT * 1024 * 2;
constexpr size_t R_F = R_B + (size_t)MT * 1024 * 2;
constexpr size_t R_G = R_F + (size_t)MKV * 1024 * 2;
constexpr size_t R_C = R_G + (size_t)MKV * 1024 * 2;
constexpr size_t R_D = R_C + (size_t)MT * 512 * 2;
constexpr size_t R_E = R_D + (size_t)MKV * 512 * 2;
constexpr size_t R_H = R_E + (size_t)MT * 1024 * 2;
constexpr size_t WS_END = R_H + (size_t)MT * 1024 * 2;
static_assert((size_t)MT * 1536 * 2 <= R_F - R_A, "Q' overlay");
static_assert((size_t)MT * DFF * 2 <= R_G - R_A, "hidden overlay");
static_assert((size_t)MT * 1024 * 2 <= R_E - R_C, "merged overlay");

constexpr int LDS_BYTES = 131072 + 64, L_XB = 131072;

struct Params {
    const float *x_p, *x_s, *cache_ckv, *cache_kr, *state_conv, *state_h, *norm1_g, *w_in, *q_norm_g, *w_uq, *kv_norm_g, *w_ukv, *qk_q_g, *qk_k_g, *conv_w, *conv_b,
        *w_rg_a, *b_rg_a, *w_rg_x, *b_rg_x, *lam, *w_pa, *w_pr, *w_out, *norm2_g, *w_fg, *w_fu, *w_fd;
    float* out; unsigned char* ws;
};

typedef __bf16 bf16x2_t __attribute__((ext_vector_type(2)));
__device__ __forceinline__ unsigned pk2(float lo, float hi) { bf16x2_t v = {(__bf16)lo, (__bf16)hi}; return __builtin_bit_cast(unsigned, v); }
__device__ __forceinline__ float bflo(unsigned u) { return __uint_as_float(u << 16); }
__device__ __forceinline__ float bfhi(unsigned u) { return __uint_as_float(u & 0xffff0000u); }
__device__ __forceinline__ float bf1(bf16_t b) { return __uint_as_float(((unsigned)b) << 16); }
__device__ __forceinline__ float wave_sum(float v) {
#pragma unroll
    for (int o = 1; o < 64; o <<= 1) v += __shfl_xor(v, o);
    return v;
}
__device__ __forceinline__ float sigmoidf_(float x) { return __builtin_amdgcn_rcpf(1.0f + __builtin_amdgcn_exp2f(-1.4426950408889634f * x)); }
__device__ __forceinline__ int my_tid() { int t = threadIdx.x; asm volatile("" : "+v"(t)); return t; }
#define LDS_WAIT() asm volatile("s_waitcnt lgkmcnt(0)" ::: "memory")
__device__ __forceinline__ int tok_pos(int R) { return R < MP ? (R & (SEQ - 1)) : (PAST + ((R - MP) & (ST - 1))); }
__device__ __forceinline__ f32x2 rope_cs(int pos, int i) {
    const float inv = (float)exp(-9.210340371976184 * (double)i / 32.0);
    const float ang = (float)pos * inv;
    const double a = (double)ang; const double k = rint(a * 0.15915494309189535); const float r = (float)(a - k * 6.283185307179586);
    f32x2 o; o.x = cosf(r); o.y = sinf(r); return o;
}

namespace pg8 {
constexpr int BM = 256, BK = 64, HALF = 128, HTB = HALF * BK * 2, STAGE_BYTES = 8 * HTB, NXCD = 8, WGM = 8;
__device__ __forceinline__ int lds_byte(int r, int c) { const int st = (r >> 4) * 2 + (c >> 5), rr = r & 15, cc = c & 31, ob = rr * 64 + cc * 2; return st * 1024 + (ob ^ (((ob >> 9) & 1) << 5)); }
__device__ __forceinline__ void stage_rc(int b, int& R, int& C) { const int st = b / 1024, sb = b % 1024, swz = sb ^ (((sb >> 9) & 1) << 5); R = (st >> 1) * 16 + swz / 64; C = (st & 1) * 32 + (swz % 64) / 2; }
__device__ __forceinline__ int perm32(int rho) { const int n = rho >> 4, i = rho & 15; return 8 * (i >> 2) + 4 * n + (i & 3); }
struct Unit { int pm, pn, g; };
__device__ __forceinline__ void tile_of(int wgid, int nM, int nN, int& pm, int& pn) {
    const int nwg = nM * nN;
    { const int q = nwg / NXCD, r = nwg % NXCD, xcd = wgid % NXCD, off = wgid / NXCD; wgid = (xcd < r ? xcd * (q + 1) : r * (q + 1) + (xcd - r) * q) + off; }
    const int nig = WGM * nN, gid = wgid / nig, fm = gid * WGM, gsz = (nM - fm) < WGM ? (nM - fm) : WGM;
    pm = fm + ((wgid % nig) % gsz); pn = (wgid % nig) / gsz;
}
template <int NG, int UPT, size_t A0, size_t B0, int nM0, int nN0, size_t A1 = 0, size_t B1 = 0, int nM1 = 0, int nN1 = 0, size_t A2 = 0, size_t B2 = 0, int nM2 = 0, int nN2 = 0> struct Order {
    const unsigned char* ws; int G, c;
    __device__ __forceinline__ bool next(int i, Unit& u) const {
        int L = (i / UPT) * G + c;
        constexpr int n0 = nM0 * nN0, n1 = nM1 * nN1, n2 = nM2 * nN2;
        if (L < n0) { tile_of(L, nM0, nN0, u.pm, u.pn); u.g = (UPT > 1) ? (i % UPT) : 0; return true; }
        if constexpr (NG > 1) { L -= n0; if (L < n1) { tile_of(L, nM1, nN1, u.pm, u.pn); u.g = 1; return true; }
            if constexpr (NG > 2) { L -= n1; if (L < n2) { tile_of(L, nM2, nN2, u.pm, u.pn); u.g = 2; return true; } } }
        return false;
    }
    __device__ __forceinline__ const char* a_of(const Unit& u) const { size_t o = A0; if constexpr (NG > 1 || UPT > 1) o = (u.g == 1) ? A1 : o; if constexpr (NG > 2) o = (u.g == 2) ? A2 : o; return (const char*)ws + o; }
    __device__ __forceinline__ const char* b_of(const Unit& u) const { size_t o = B0; if constexpr (NG > 1 || UPT > 1) o = (u.g == 1) ? B1 : o; if constexpr (NG > 2) o = (u.g == 2) ? B2 : o; return (const char*)ws + o; }
};

template <class Epi, class Sched>
__device__ __forceinline__ void gemm_phase(LAS unsigned char* lds, const int K, const Sched& S, const Epi& E) {
    const int tid = my_tid(), wid = __builtin_amdgcn_readfirstlane(tid >> 6), lane = tid & 63, wr = wid >> 2, wc = wid & 3, fr = lane & 15, fq = lane >> 4;
    const int nt = K / BK;
    unsigned voffA[2], voffB[2];
#pragma unroll
    for (int i = 0; i < 2; ++i) { int R, C; stage_rc(tid * 16 + i * 8192, R, C); const int Rb = (R & ~31) + perm32(R & 31);
        voffA[i] = (unsigned)(R * K + C) * 2u; voffB[i] = (unsigned)(Rb * K + C) * 2u; }
    const size_t kstep = (size_t)(BK * 2);
    const size_t hstep = (size_t)HALF * K * 2;
    const size_t tstep = 2 * hstep;
    const unsigned ldsw = (unsigned)wid * 1024u;
    const int aoff = lds_byte(wr * 64 + fr, fq * 8), boff = lds_byte(wc * 32 + fr, fq * 8);
#define PG8_SA(b, h) (((b) * 2 + (h)) * HTB)
#define PG8_SB(b, h) ((4 + (b) * 2 + (h)) * HTB)
#define PG8_STAGE(bufoff, gbase, voff) do { _Pragma("unroll") for (int _i = 0; _i < 2; ++_i) \
        __builtin_amdgcn_global_load_lds((const unsigned*)((const char*)(gbase) + (voff)[_i]), (LAS unsigned*)(lds + (bufoff) + ldsw + _i * 8192), 16, 0, 0); } while (0)
#define PG8_LDA(dst, b, h) do { _Pragma("unroll") for (int m = 0; m < 4; ++m) _Pragma("unroll") for (int k = 0; k < 2; ++k) dst[m][k] = *(const LAS bf16x8*)(lds + PG8_SA(b, h) + aoff + m * 2048 + k * 1024); } while (0)
#define PG8_LDB(dst, b, h) do { _Pragma("unroll") for (int n = 0; n < 2; ++n) _Pragma("unroll") for (int k = 0; k < 2; ++k) dst[n][k] = *(const LAS bf16x8*)(lds + PG8_SB(b, h) + boff + n * 2048 + k * 1024); } while (0)
#define PG8_MMA(ai, bj, At, Bt) do { __builtin_amdgcn_s_setprio(1); _Pragma("unroll") for (int m = 0; m < 4; ++m) _Pragma("unroll") for (int n = 0; n < 2; ++n) _Pragma("unroll") for (int k = 0; k < 2; ++k) \
        acc[ai][bj][m][n] = __builtin_amdgcn_mfma_f32_16x16x32_bf16(Bt[n][k], At[m][k], acc[ai][bj][m][n], 0, 0, 0); __builtin_amdgcn_s_setprio(0); } while (0)
#define PG8_WAIT_V(n) asm volatile("s_waitcnt vmcnt(" #n ")" ::: "memory")
#define PG8_WAIT_L(n) asm volatile("s_waitcnt lgkmcnt(" #n ")" ::: "memory")
#define PG8_BAR __builtin_amdgcn_s_barrier()
#define PG8_SCHED __builtin_amdgcn_sched_barrier(0)
    Unit cur, nxt; int ui = 0;
    if (!S.next(0, cur)) return;
    f32x4 acc[2][2][4][2];
#pragma unroll
    for (int a = 0; a < 2; ++a)
#pragma unroll
        for (int b = 0; b < 2; ++b)
#pragma unroll
            for (int m = 0; m < 4; ++m)
#pragma unroll
                for (int n = 0; n < 2; ++n) acc[a][b][m][n] = (f32x4){0.f, 0.f, 0.f, 0.f};
    bf16x8 At[4][2], B0[2][2], B1[2][2];
    const char* cA = S.a_of(cur) + (size_t)cur.pm * tstep; const char* cB = S.b_of(cur) + (size_t)cur.pn * tstep;
    PG8_STAGE(PG8_SB(0, 0), cB, voffB); PG8_STAGE(PG8_SA(0, 0), cA, voffA); PG8_STAGE(PG8_SB(0, 1), cB + hstep, voffB); PG8_STAGE(PG8_SA(0, 1), cA + hstep, voffA);
    if (wr == 1) PG8_BAR;
    PG8_WAIT_V(4); PG8_BAR;
    PG8_STAGE(PG8_SB(1, 0), cB + kstep, voffB); PG8_STAGE(PG8_SA(1, 0), cA + kstep, voffA); PG8_STAGE(PG8_SB(1, 1), cB + hstep + kstep, voffB);
    PG8_WAIT_V(6); PG8_BAR;
    for (;;) {
        const bool has_next = S.next(ui + 1, nxt);
        const char* nA = has_next ? S.a_of(nxt) + (size_t)nxt.pm * tstep : cA; const char* nB = has_next ? S.b_of(nxt) + (size_t)nxt.pn * tstep : cB;
        for (int t = 0; t < nt; t += 2) {
            const bool last = (t == nt - 2);
            const char* a1 = cA + (size_t)(t + 1) * kstep;
            const char* a2 = last ? nA : cA + (size_t)(t + 2) * kstep; const char* b2 = last ? nB : cB + (size_t)(t + 2) * kstep;
            const char* a3 = a2 + kstep; const char* b3 = b2 + kstep;
            PG8_LDB(B0, 0, 0); PG8_SCHED; PG8_LDA(At, 0, 0); PG8_STAGE(PG8_SA(1, 1), a1 + hstep, voffA);
            PG8_WAIT_L(8); PG8_BAR; PG8_WAIT_L(0); PG8_MMA(0, 0, At, B0); PG8_BAR; PG8_SCHED;
            PG8_LDB(B1, 0, 1); PG8_STAGE(PG8_SB(0, 0), b2, voffB);
            PG8_BAR; PG8_WAIT_L(0); PG8_MMA(0, 1, At, B1); PG8_BAR;
            PG8_LDA(At, 0, 1); PG8_STAGE(PG8_SA(0, 0), a2, voffA);
            PG8_BAR; PG8_WAIT_L(0); PG8_MMA(1, 0, At, B0); PG8_BAR; PG8_SCHED;
            PG8_STAGE(PG8_SB(0, 1), b2 + hstep, voffB);
            PG8_WAIT_V(6); PG8_BAR; PG8_MMA(1, 1, At, B1); PG8_BAR;
            PG8_LDB(B0, 1, 0); PG8_SCHED; PG8_LDA(At, 1, 0); PG8_STAGE(PG8_SA(0, 1), a2 + hstep, voffA);
            PG8_WAIT_L(8); PG8_BAR; PG8_WAIT_L(0); PG8_MMA(0, 0, At, B0); PG8_BAR; PG8_SCHED;
            PG8_LDB(B1, 1, 1); PG8_STAGE(PG8_SB(1, 0), b3, voffB);
            PG8_BAR; PG8_WAIT_L(0); PG8_MMA(0, 1, At, B1); PG8_BAR;
            PG8_LDA(At, 1, 1); PG8_STAGE(PG8_SA(1, 0), a3, voffA);
            PG8_BAR; PG8_WAIT_L(0); PG8_MMA(1, 0, At, B0); PG8_BAR; PG8_SCHED;
            PG8_STAGE(PG8_SB(1, 1), b3 + hstep, voffB);
            PG8_WAIT_V(6); PG8_BAR; PG8_MMA(1, 1, At, B1); PG8_BAR;
        }
        E(acc, cur, wr, wc, fr, fq);
        if (!has_next) break;
        if (!E.keep_acc(cur))
#pragma unroll
        for (int a = 0; a < 2; ++a)
#pragma unroll
            for (int b = 0; b < 2; ++b)
#pragma unroll
                for (int m = 0; m < 4; ++m)
#pragma unroll
                    for (int n = 0; n < 2; ++n) acc[a][b][m][n] = (f32x4){0.f, 0.f, 0.f, 0.f};
        cur = nxt; cA = nA; cB = nB; ++ui;
    }
    PG8_WAIT_V(0);
    if (wr == 0) PG8_BAR;
    PG8_BAR;
#undef PG8_SA
#undef PG8_SB
#undef PG8_STAGE
#undef PG8_LDA
#undef PG8_LDB
#undef PG8_MMA
#undef PG8_WAIT_V
#undef PG8_WAIT_L
#undef PG8_BAR
#undef PG8_SCHED
}
}
using pg8::Unit;

typedef f32x4 Acc[2][2][4][2];
__device__ __forceinline__ u32x4 pack8(f32x4 a, f32x4 b) { u32x4 w; w.x = pk2(a[0], a[1]); w.y = pk2(a[2], a[3]); w.z = pk2(b[0], b[1]); w.w = pk2(b[2], b[3]); return w; }
__device__ __forceinline__ float sq8(f32x4 a, f32x4 b) { return (a[0] * a[0] + a[1] * a[1]) + (a[2] * a[2] + a[3] * a[3]) + (b[0] * b[0] + b[1] * b[1]) + (b[2] * b[2] + b[3] * b[3]); }
__device__ __forceinline__ float red_fq(float s) { s += __shfl_xor(s, 16); s += __shfl_xor(s, 32); return s; }

template <int PH> struct Epi {
    Params P;
    __device__ __forceinline__ bool keep_acc(const Unit& u) const { return PH == 5 && u.g == 0; }
    __device__ __forceinline__ void operator()(Acc& acc, const Unit& u, int wr, int wc, int fr, int fq) const {
        unsigned char* ws = P.ws;
        const int row0 = u.pm * 256 + wr * 64 + fr;
        const int cl0 = wc * 32 + 8 * fq;
        if constexpr (PH == 1) {
            const int pn = u.pn;
            if (pn < 2) {
                bf16_t* O = (bf16_t*)(ws + R_C); float* ssq = (float*)(ws + W_SSQ_CQ);
#pragma unroll
                for (int ai = 0; ai < 2; ++ai)
#pragma unroll
                    for (int m = 0; m < 4; ++m) { const int R = row0 + ai * 128 + m * 16; float s = 0.f;
#pragma unroll
                        for (int bj = 0; bj < 2; ++bj) { *(u32x4*)(O + (size_t)R * 512 + pn * 256 + bj * 128 + cl0) = pack8(acc[ai][bj][m][0], acc[ai][bj][m][1]); s += sq8(acc[ai][bj][m][0], acc[ai][bj][m][1]); }
                        s = red_fq(s); if (fq == 0) unsafeAtomicAdd(ssq + R, s); }
            } else if (pn < 4) {
                bf16_t* O = (bf16_t*)(ws + R_D); float* ssq = (float*)(ws + W_SSQ_CKV);
#pragma unroll
                for (int ai = 0; ai < 2; ++ai)
#pragma unroll
                    for (int m = 0; m < 4; ++m) { const int R = row0 + ai * 128 + m * 16; float s = 0.f;
#pragma unroll
                        for (int bj = 0; bj < 2; ++bj) { *(u32x4*)(O + (size_t)R * 512 + (pn - 2) * 256 + bj * 128 + cl0) = pack8(acc[ai][bj][m][0], acc[ai][bj][m][1]); s += sq8(acc[ai][bj][m][0], acc[ai][bj][m][1]); }
                        s = red_fq(s); if (fq == 0) unsafeAtomicAdd(ssq + R, s); }
            } else if (pn < 8) {
                bf16_t* O = (bf16_t*)(ws + R_B);
#pragma unroll
                for (int ai = 0; ai < 2; ++ai)
#pragma unroll
                    for (int m = 0; m < 4; ++m) { const int R = row0 + ai * 128 + m * 16;
#pragma unroll
                        for (int bj = 0; bj < 2; ++bj) *(u32x4*)(O + (size_t)R * 1024 + (pn - 4) * 256 + bj * 128 + cl0) = pack8(acc[ai][bj][m][0], acc[ai][bj][m][1]); }
            } else if (pn < 16) {
                const int which = (pn - 8) >> 2, ct = (pn - 8) & 3;
                bf16_t* O = u.pm < 256 ? (bf16_t*)P.out + (size_t)which * MP * 1024 : (bf16_t*)(ws + W_GS) + (size_t)which * 256 * 1024 - (size_t)MP * 1024;
#pragma unroll
                for (int ai = 0; ai < 2; ++ai)
#pragma unroll
                    for (int m = 0; m < 4; ++m) { const int R = row0 + ai * 128 + m * 16;
#pragma unroll
                        for (int bj = 0; bj < 2; ++bj) { f32x4 a = acc[ai][bj][m][0], b = acc[ai][bj][m][1];
#pragma unroll
                            for (int j = 0; j < 4; ++j) { a[j] = sigmoidf_(a[j]); b[j] = sigmoidf_(b[j]); }
                            *(u32x4*)(O + (size_t)R * 1024 + ct * 256 + bj * 128 + cl0) = pack8(a, b); } }
            } else {
                if (wc < 2) {
#pragma unroll
                    for (int ai = 0; ai < 2; ++ai)
#pragma unroll
                        for (int m = 0; m < 4; ++m) { const int R = row0 + ai * 128 + m * 16;
                            if (R < MP + MS) { float* d = (R < MP ? P.out + O_KRP + (size_t)R * 64 : P.out + O_KRS + (size_t)(R - MP) * 64) + cl0; *(f32x4*)d = acc[ai][0][m][0]; *(f32x4*)(d + 4) = acc[ai][0][m][1]; } }
                }
            }
        } else if constexpr (PH == 3) {
            if (u.g == 0) {
                bf16_t* Q = (bf16_t*)(ws + R_A); float* ssq = (float*)(ws + W_SSQ_Q); const float* ssq_cq = (const float*)(ws + W_SSQ_CQ);
                const f32x4* cs = (const f32x4*)(ws + W_CS);
                int c8[2], hd[2], i0[2]; bool rope[2]; f32x4 g0[2], g1[2];
#pragma unroll
                for (int bj = 0; bj < 2; ++bj) { c8[bj] = u.pn * 256 + bj * 128 + cl0; hd[bj] = c8[bj] / 192; const int cin = c8[bj] - hd[bj] * 192; rope[bj] = __builtin_amdgcn_readfirstlane(cin >= 128 ? 1 : 0) != 0; i0[bj] = (cin - 128) >> 1;
                    if (rope[bj]) { g0[bj] = *(const f32x4*)(P.qk_q_g + 128 + i0[bj]); g1[bj] = *(const f32x4*)(P.qk_q_g + 160 + i0[bj]); }
                    else { g0[bj] = *(const f32x4*)(P.qk_q_g + cin); g1[bj] = *(const f32x4*)(P.qk_q_g + cin + 4); } }
#pragma unroll
                for (int ai = 0; ai < 2; ++ai) {
                    float rsv[4]; f32x4 csa[4], csb[4];
#pragma unroll
                    for (int m = 0; m < 4; ++m) { const int R = row0 + ai * 128 + m * 16; rsv[m] = ssq_cq[R];
                        const int pos = tok_pos(R < MP + MS ? R : 0);
                        if (rope[0] || rope[1]) { const int ir = rope[0] ? i0[0] : i0[1]; csa[m] = cs[(pos * 32 + ir) >> 1]; csb[m] = cs[((pos * 32 + ir) >> 1) + 1]; } }
#pragma unroll
                    for (int m = 0; m < 4; ++m) { const int R = row0 + ai * 128 + m * 16;
                        const float rs = __builtin_amdgcn_rsqf(rsv[m] * (1.0f / 512.0f) + EPS);
#pragma unroll
                        for (int bj = 0; bj < 2; ++bj) { const f32x4 a = acc[ai][bj][m][0] * rs, b = acc[ai][bj][m][1] * rs;
                            const float s = red_fq(sq8(a, b)); if (fq == 0) unsafeAtomicAdd(ssq + (size_t)R * 8 + hd[bj], s);
                            u32x4 o;
                            if (!rope[bj]) o = pack8(a * g0[bj], b * g1[bj]);
                            else { const f32x4 ga = g0[bj], gb = g1[bj], cs0 = csa[m], cs1 = csb[m]; f32x4 o0, o1;
                                { const float x1 = a[0] * ga[0], x2 = a[1] * gb[0]; o0[0] = x1 * cs0[0] - x2 * cs0[1]; o0[1] = x1 * cs0[1] + x2 * cs0[0]; }
                                { const float x1 = a[2] * ga[1], x2 = a[3] * gb[1]; o0[2] = x1 * cs0[2] - x2 * cs0[3]; o0[3] = x1 * cs0[3] + x2 * cs0[2]; }
                                { const float x1 = b[0] * ga[2], x2 = b[1] * gb[2]; o1[0] = x1 * cs1[0] - x2 * cs1[1]; o1[1] = x1 * cs1[1] + x2 * cs1[0]; }
                                { const float x1 = b[2] * ga[3], x2 = b[3] * gb[3]; o1[2] = x1 * cs1[2] - x2 * cs1[3]; o1[3] = x1 * cs1[3] + x2 * cs1[2]; }
                                o = pack8(o0, o1); }
                            *(u32x4*)(Q + (size_t)R * 1536 + c8[bj]) = o; } } }
            } else if (u.g == 1) {
                bf16_t* O = (bf16_t*)(ws + R_F); float* ssq = (float*)(ws + W_SSQ_K);
                const f32x4 g0 = *(const f32x4*)(P.qk_k_g + cl0), g1 = *(const f32x4*)(P.qk_k_g + cl0 + 4);
#pragma unroll
                for (int ai = 0; ai < 2; ++ai)
#pragma unroll
                    for (int m = 0; m < 4; ++m) { const int R = row0 + ai * 128 + m * 16;
#pragma unroll
                        for (int bj = 0; bj < 2; ++bj) { const f32x4 a = acc[ai][bj][m][0], b = acc[ai][bj][m][1];
                            float s = red_fq(sq8(a, b)); if (fq == 0) unsafeAtomicAdd(ssq + (size_t)R * 8 + u.pn * 2 + bj, s);
                            *(u32x4*)(O + (size_t)R * 1024 + u.pn * 256 + bj * 128 + cl0) = pack8(a * g0, b * g1); } }
            } else {
                bf16_t* O = (bf16_t*)(ws + R_G);
#pragma unroll
                for (int ai = 0; ai < 2; ++ai)
#pragma unroll
                    for (int m = 0; m < 4; ++m) { const int R = row0 + ai * 128 + m * 16;
#pragma unroll
                        for (int bj = 0; bj < 2; ++bj) {
                            const int c8 = u.pn * 256 + bj * 128 + cl0, hf = (c8 >> 3) & 1; bf16_t* o = O + (size_t)R * MKV + (c8 & ~15) + 4 * hf;
                            const f32x4 a = acc[ai][bj][m][0], b = acc[ai][bj][m][1];
                            *(u32x2*)o = (u32x2){pk2(a[0], a[1]), pk2(a[2], a[3])}; *(u32x2*)(o + 8) = (u32x2){pk2(b[0], b[1]), pk2(b[2], b[3])}; } }
            }
        } else if constexpr (PH == 5) {
            bf16_t* O = (bf16_t*)(ws + R_C);
            const bf16_t* G0 = u.pm < 256 ? (const bf16_t*)P.out : (const bf16_t*)(ws + W_GS) - (size_t)MP * 1024;
            const bf16_t* G1 = u.pm < 256 ? (const bf16_t*)P.out + (size_t)MP * 1024 : (const bf16_t*)(ws + W_GS) + (size_t)256 * 1024 - (size_t)MP * 1024;
#pragma unroll
            for (int ai = 0; ai < 2; ++ai) {
                u32x4 ga[4][2], gb[4][2];
#pragma unroll
                for (int m = 0; m < 4; ++m)
#pragma unroll
                    for (int bj = 0; bj < 2; ++bj) { const size_t o = (size_t)(row0 + ai * 128 + m * 16) * 1024 + u.pn * 256 + bj * 128 + cl0; gb[m][bj] = *(const u32x4*)(G1 + o); if (u.g == 0) ga[m][bj] = *(const u32x4*)(G0 + o); }
#pragma unroll
                for (int m = 0; m < 4; ++m)
#pragma unroll
                    for (int bj = 0; bj < 2; ++bj) { const size_t o = (size_t)(row0 + ai * 128 + m * 16) * 1024 + u.pn * 256 + bj * 128 + cl0;
                        const u32x4 b4 = gb[m][bj];
                        float fb[8] = {bflo(b4.x), bfhi(b4.x), bflo(b4.y), bfhi(b4.y), bflo(b4.z), bfhi(b4.z), bflo(b4.w), bfhi(b4.w)};
                        if (u.g == 0) { const u32x4 a4 = ga[m][bj];
                            const float fa[8] = {bflo(a4.x), bfhi(a4.x), bflo(a4.y), bfhi(a4.y), bflo(a4.z), bfhi(a4.z), bflo(a4.w), bfhi(a4.w)};
#pragma unroll
                            for (int j = 0; j < 4; ++j) { acc[ai][bj][m][0][j] *= fa[j] * __builtin_amdgcn_rcpf(fmaxf(fb[j], 1e-20f)); acc[ai][bj][m][1][j] *= fa[4 + j] * __builtin_amdgcn_rcpf(fmaxf(fb[4 + j], 1e-20f)); }
                        } else { f32x4 a = acc[ai][bj][m][0], b = acc[ai][bj][m][1];
#pragma unroll
                            for (int j = 0; j < 4; ++j) { a[j] *= fb[j]; b[j] *= fb[4 + j]; }
                            *(u32x4*)(O + o) = pack8(a, b); } } }
        } else if constexpr (PH == 6) {
            bf16_t* O = (bf16_t*)(ws + R_E); float* ssq = (float*)(ws + W_SSQ2);
#pragma unroll
            for (int ai = 0; ai < 2; ++ai) {
                f32x4 xv[4][2][2];
#pragma unroll
                for (int m = 0; m < 4; ++m) { const int R = row0 + ai * 128 + m * 16; const int Rc = R < MP + MS ? R : 0;
                    const float* xs = Rc < MP ? P.x_p + (size_t)Rc * 1024 : P.x_s + (size_t)(Rc - MP) * 1024;
#pragma unroll
                    for (int bj = 0; bj < 2; ++bj) { const int c = u.pn * 256 + bj * 128 + cl0; xv[m][bj][0] = *(const f32x4*)(xs + c); xv[m][bj][1] = *(const f32x4*)(xs + c + 4); } }
#pragma unroll
                for (int m = 0; m < 4; ++m) { const int R = row0 + ai * 128 + m * 16; float s = 0.f;
                    const bool valid = R < MP + MS;
#pragma unroll
                    for (int bj = 0; bj < 2; ++bj) { const int c = u.pn * 256 + bj * 128 + cl0;
                        f32x4 a = acc[ai][bj][m][0], b = acc[ai][bj][m][1];
                        if (valid) { a += xv[m][bj][0]; b += xv[m][bj][1]; }
                        else { a = (f32x4){0.f, 0.f, 0.f, 0.f}; b = a; }
                        s += sq8(a, b);
                        *(u32x4*)(O + (size_t)R * 1024 + c) = pack8(a, b); }
                    s = red_fq(s); if (fq == 0) unsafeAtomicAdd(ssq + R, s); } }
        } else if constexpr (PH == 7) {
            bf16_t* O = (bf16_t*)(ws + R_A); const float* ssq = (const float*)(ws + W_SSQ2);
            float rsv[2][4];
#pragma unroll
            for (int ai = 0; ai < 2; ++ai)
#pragma unroll
                for (int m = 0; m < 4; ++m) rsv[ai][m] = ssq[row0 + ai * 128 + m * 16];
#pragma unroll
            for (int ai = 0; ai < 2; ++ai)
#pragma unroll
                for (int m = 0; m < 4; ++m) { const int R = row0 + ai * 128 + m * 16;
                    const float rs = __builtin_amdgcn_rsqf(rsv[ai][m] * (1.0f / 1024.0f) + EPS);
                    f32x4 o[2];
#pragma unroll
                    for (int n = 0; n < 2; ++n)
#pragma unroll
                        for (int j = 0; j < 4; ++j) { const float g = acc[ai][0][m][n][j] * rs, up = acc[ai][1][m][n][j] * rs; o[n][j] = g * sigmoidf_(g) * up; }
                    *(u32x4*)(O + (size_t)R * DFF + u.pn * 128 + cl0) = pack8(o[0], o[1]); }
        } else if constexpr (PH == 8) {
            const bf16_t* X1 = (const bf16_t*)(ws + R_E);
#pragma unroll
            for (int ai = 0; ai < 2; ++ai) {
                u32x4 xv[4][2];
#pragma unroll
                for (int m = 0; m < 4; ++m)
#pragma unroll
                    for (int bj = 0; bj < 2; ++bj) xv[m][bj] = *(const u32x4*)(X1 + (size_t)(row0 + ai * 128 + m * 16) * 1024 + u.pn * 256 + bj * 128 + cl0);
#pragma unroll
                for (int m = 0; m < 4; ++m) { const int R = row0 + ai * 128 + m * 16;
                    if (R < MP + MS) { float* ys = R < MP ? P.out + O_YP + (size_t)R * 1024 : P.out + O_YS + (size_t)(R - MP) * 1024;
#pragma unroll
                        for (int bj = 0; bj < 2; ++bj) { float* y = ys + u.pn * 256 + bj * 128 + cl0; const u32x4 v = xv[m][bj];
                            *(f32x4*)y = (f32x4){bflo(v.x), bfhi(v.x), bflo(v.y), bfhi(v.y)} + acc[ai][bj][m][0]; *(f32x4*)(y + 4) = (f32x4){bflo(v.z), bfhi(v.z), bflo(v.w), bfhi(v.w)} + acc[ai][bj][m][1]; } } } }
        }
    }
};

template <class DstFn>
__device__ __forceinline__ void tp_matrix(const float* W, int K, int N, const float* ks, bf16_t* Wt, int ldt, DstFn dst, LAS float* scr, int gw, int ngw, int lane, int& off) {
    const int nblk = N / 32, nitems = (K / 64) * nblk;
    int start = (gw - off) % ngw; if (start < 0) start += ngw;
    off = (off + nitems) % ngw;
    for (int it = start; it < nitems; it += ngw) {
        const int k0 = 64 * (it / nblk), n0 = 32 * (it % nblk);
        const int c4 = lane & 7, kr = lane >> 3;
        f32x4 v[8];
#pragma unroll
        for (int i = 0; i < 8; ++i) v[i] = *(const f32x4*)(W + (size_t)(k0 + kr + 8 * i) * N + n0 + 4 * c4);
#pragma unroll
        for (int i = 0; i < 8; ++i) { const int kk = kr + 8 * i; const float sc = ks ? ks[k0 + kk] : 1.0f;
#pragma unroll
            for (int e = 0; e < 4; ++e) scr[kk * 33 + 4 * c4 + e] = v[i][e] * sc; }
        LDS_WAIT();
        const int c = lane & 7;
#pragma unroll
        for (int j = 0; j < 4; ++j) { const int n = (lane >> 3) + 8 * j; const LAS float* s = scr + (8 * c) * 33 + n;
            u32x4 o; o.x = pk2(s[0 * 33], s[1 * 33]); o.y = pk2(s[2 * 33], s[3 * 33]); o.z = pk2(s[4 * 33], s[5 * 33]); o.w = pk2(s[6 * 33], s[7 * 33]);
            const int dr = dst(n0 + n);
            *(u32x4*)(Wt + (size_t)dr * ldt + k0 + 8 * c) = o; }
        LDS_WAIT();
    }
}
template <bool TABLE>
__device__ __forceinline__ void kr_row(const Params& P, const float* raw, int pos, bf16_t* dst, float* ssq, int i) {
    const float x1 = raw[i], x2 = raw[32 + i];
    float s = x1 * x1 + x2 * x2;
#pragma unroll
    for (int o = 1; o < 32; o <<= 1) s += __shfl_xor(s, o);
    const f32x2 cs = TABLE ? ((const f32x2*)(P.ws + W_CS))[pos * 32 + i] : rope_cs(pos, i);
    const float a = x1 * P.qk_k_g[128 + i], b = x2 * P.qk_k_g[160 + i];
    ((unsigned*)dst)[i] = pk2(a * cs.x - b * cs.y, a * cs.y + b * cs.x);
    if (i == 0) *ssq = s;
}
__device__ __forceinline__ void phase0(const Params& P, LAS unsigned char* lds) {
    unsigned char* ws = P.ws;
    const int tid = my_tid(), lane = tid & 63, wave = tid >> 6;
    const int gw = blockIdx.x * 8 + wave, ngw = gridDim.x * 8;
    const size_t gt = (size_t)blockIdx.x * 512 + tid, ngt = (size_t)gridDim.x * 512;
    LAS float* scr = (LAS float*)(lds + wave * 16384);
    for (size_t i = gt; i < (W_SSQ_END - W_SSQ0) / 16; i += ngt) ((u32x4*)(ws + W_SSQ0))[i] = (u32x4){0u, 0u, 0u, 0u};
    for (size_t i = gt; i < (size_t)192 * 1024 * 2 / 16; i += ngt) ((u32x4*)(ws + W_IN + (size_t)(16 * 256 + 64) * 1024 * 2))[i] = (u32x4){0u, 0u, 0u, 0u};
    for (size_t i = gt; i < (size_t)4096 * 32; i += ngt) ((f32x2*)(ws + W_CS))[i] = rope_cs((int)(i >> 5), (int)(i & 31));
    int toff = 0;
    tp_matrix(P.w_in, 1024, 4160, nullptr, (bf16_t*)(ws + W_IN), 1024, [](int n) { return n < 1024 ? n : (n < 1088 ? 4096 + (n - 1024) : n - 1088 + 1024); }, scr, gw, ngw, lane, toff);
    tp_matrix(P.w_uq, 512, 1536, P.q_norm_g, (bf16_t*)(ws + W_UQ), 512, [](int n) { const int h = n / 192, j = n % 192; return h * 192 + (j < 128 ? j : (j < 160 ? 128 + 2 * (j - 128) : 129 + 2 * (j - 160))); }, scr, gw, ngw, lane, toff);
    tp_matrix(P.w_ukv, 512, 2048, nullptr, (bf16_t*)(ws + W_UK), 512, [](int n) { const int h = n >> 8, j = n & 255; return j < 128 ? h * 128 + j : 1024 + h * 128 + (j - 128); }, scr, gw, ngw, lane, toff);
    tp_matrix(P.w_pa, 1024, 1024, nullptr, (bf16_t*)(ws + W_PA), 1024, [](int n) { return n; }, scr, gw, ngw, lane, toff);
    tp_matrix(P.w_pr, 1024, 1024, nullptr, (bf16_t*)(ws + W_PR), 1024, [](int n) { return n; }, scr, gw, ngw, lane, toff);
    tp_matrix(P.w_out, 1024, 1024, nullptr, (bf16_t*)(ws + W_OUT), 1024, [](int n) { return n; }, scr, gw, ngw, lane, toff);
    tp_matrix(P.w_fg, 1024, DFF, P.norm2_g, (bf16_t*)(ws + W_GU), 1024, [](int n) { return (n >> 7) * 256 + (n & 127); }, scr, gw, ngw, lane, toff);
    tp_matrix(P.w_fu, 1024, DFF, P.norm2_g, (bf16_t*)(ws + W_GU), 1024, [](int n) { return (n >> 7) * 256 + 128 + (n & 127); }, scr, gw, ngw, lane, toff);
    tp_matrix(P.w_fd, DFF, 1024, nullptr, (bf16_t*)(ws + W_D), DFF, [](int n) { return n; }, scr, gw, ngw, lane, toff);
    for (int b = 0; b < 8; ++b) {
        tp_matrix(P.w_rg_a + b * 16384, 128, 128, nullptr, (bf16_t*)(ws + W_RA) + b * 16384, 128, [](int n) { return n; }, scr, gw, ngw, lane, toff);
        tp_matrix(P.w_rg_x + b * 16384, 128, 128, nullptr, (bf16_t*)(ws + W_RX) + b * 16384, 128, [](int n) { return n; }, scr, gw, ngw, lane, toff);
    }
    { f32x4 g1[4];
#pragma unroll
      for (int j = 0; j < 4; ++j) g1[j] = ((const f32x4*)P.norm1_g)[lane + 64 * j];
      for (int R0 = gw; R0 < MT; R0 += 4 * ngw) {
        f32x4 v[4][4];
#pragma unroll
        for (int u = 0; u < 4; ++u) { const int R = R0 + u * ngw; const int Rc = R < MP + MS ? R : 0;
            const f32x4* xr = (const f32x4*)(Rc < MP ? P.x_p + (size_t)Rc * 1024 : P.x_s + (size_t)(Rc - MP) * 1024) + lane;
#pragma unroll
            for (int j = 0; j < 4; ++j) v[u][j] = xr[64 * j]; }
#pragma unroll
        for (int u = 0; u < 4; ++u) { const int R = R0 + u * ngw;
            if (R < MT) { u32x2* o = (u32x2*)(ws + R_A + (size_t)R * 2048) + lane; float s = 0.f;
#pragma unroll
                for (int j = 0; j < 4; ++j) s += (v[u][j].x * v[u][j].x + v[u][j].y * v[u][j].y) + (v[u][j].z * v[u][j].z + v[u][j].w * v[u][j].w);
                const float rs = R < MP + MS ? __builtin_amdgcn_rsqf(wave_sum(s) * (1.0f / 1024.0f) + EPS) : 0.f;
#pragma unroll
                for (int j = 0; j < 4; ++j) { const f32x4 g = g1[j] * rs; u32x2 w; w.x = pk2(v[u][j].x * g.x, v[u][j].y * g.y); w.y = pk2(v[u][j].z * g.z, v[u][j].w * g.w); o[64 * j] = w; } } }
      } }
    for (size_t i = gt; i < (size_t)SB * PAST * 512 / 8; i += ngt) { const f32x4 a = ((const f32x4*)P.cache_ckv)[2 * i], b = ((const f32x4*)P.cache_ckv)[2 * i + 1];
        ((u32x4*)(ws + R_D + (size_t)R_PAST0 * 512 * 2))[i] = pack8(a, b); }
    for (size_t i = gt; i < (size_t)SB * PAST * 32; i += ngt) { const int idx = (int)(i >> 5); kr_row<false>(P, P.cache_kr + (size_t)idx * 64, idx & (PAST - 1), (bf16_t*)(ws + W_KR) + (size_t)(R_PAST0 + idx) * 64, (float*)(ws + W_SSQ_KR) + R_PAST0 + idx, (int)(i & 31)); }
}

__device__ __forceinline__ f32x16 mfma32(bf16x8 a, bf16x8 b, f32x16 c) { return __builtin_amdgcn_mfma_f32_32x32x16_bf16(a, b, c, 0, 0, 0); }

constexpr int XC_PITCH = 272, WG_PITCH = 272;
constexpr int L_XC = 0, L_WA = L_XC + 256 * XC_PITCH, L_WX = L_WA + 64 * WG_PITCH, L_AGG = L_WX + 64 * WG_PITCH;

__device__ __forceinline__ void rnn_chain(const Params& P, LAS unsigned char* lds, int Rbase, int ntiles, int nvalid, int n, int jh, const float* hist, const float* h0, float* hlast) {
    unsigned char* ws = P.ws;
    const int tid = my_tid(), lane = tid & 63, w = tid >> 6, r = lane & 31, hh = lane >> 5;
    const bf16_t* Xr = (const bf16_t*)(ws + R_B); bf16_t* Hs = (bf16_t*)(ws + R_E);
    __syncthreads();
    for (int i = tid; i < 64 * 16; i += 512) { const int j = i >> 4, c = i & 15;
        *(LAS u32x4*)(lds + L_WA + j * WG_PITCH + c * 16) = *(const u32x4*)((const bf16_t*)(ws + W_RA) + (size_t)n * 16384 + (jh * 64 + j) * 128 + c * 8);
        *(LAS u32x4*)(lds + L_WX + j * WG_PITCH + c * 16) = *(const u32x4*)((const bf16_t*)(ws + W_RX) + (size_t)n * 16384 + (jh * 64 + j) * 128 + c * 8); }
    const int c16 = tid & 15, run = tid >> 4, ch0 = n * 128 + c16 * 8;
    float cw[4][8], cb[8];
#pragma unroll
    for (int j = 0; j < 4; ++j) { const f32x4 a = *(const f32x4*)(P.conv_w + j * 1024 + ch0), b = *(const f32x4*)(P.conv_w + j * 1024 + ch0 + 4);
#pragma unroll
        for (int e = 0; e < 4; ++e) { cw[j][e] = a[e]; cw[j][4 + e] = b[e]; } }
    { const f32x4 a = *(const f32x4*)(P.conv_b + ch0), b = *(const f32x4*)(P.conv_b + ch0 + 4);
#pragma unroll
        for (int e = 0; e < 4; ++e) { cb[e] = a[e]; cb[4 + e] = b[e]; } }
    float ba[2], bx[2], sp[2], carry[2];
#pragma unroll
    for (int ct = 0; ct < 2; ++ct) { const int ch = n * 128 + jh * 64 + ct * 32 + r; ba[ct] = P.b_rg_a[ch]; bx[ct] = P.b_rg_x[ch]; sp[ct] = -8.0f * 1.4426950408889634f * log1pf(expf(-P.lam[ch])); carry[ct] = h0 ? h0[ch] : 0.f; }
    u32x4 xr[11];
#pragma unroll
    for (int k = 0; k < 11; ++k) { const int t = run * 8 - 3 + k; xr[k] = *(const u32x4*)(Xr + (size_t)(Rbase + (t < 0 ? 0 : t)) * 1024 + ch0); }
    for (int tile = 0; tile < ntiles; ++tile) {
        const int R0 = Rbase + tile * 256;
        {
            float xw[3][8];
#pragma unroll
            for (int k = 0; k < 3; ++k) { const int t = tile * 256 + run * 8 - 3 + k;
                if (t >= 0) { const u32x4 v = xr[k];
                    xw[k][0] = bflo(v.x); xw[k][1] = bfhi(v.x); xw[k][2] = bflo(v.y); xw[k][3] = bfhi(v.y); xw[k][4] = bflo(v.z); xw[k][5] = bfhi(v.z); xw[k][6] = bflo(v.w); xw[k][7] = bfhi(v.w); }
                else if (hist) { const f32x4 a = *(const f32x4*)(hist + (3 + t) * 1024 + ch0), b = *(const f32x4*)(hist + (3 + t) * 1024 + ch0 + 4);
#pragma unroll
                    for (int e = 0; e < 4; ++e) { xw[k][e] = a[e]; xw[k][4 + e] = b[e]; } }
                else {
#pragma unroll
                    for (int e = 0; e < 8; ++e) xw[k][e] = 0.f; } }
#pragma unroll
            for (int rr = 0; rr < 8; ++rr) {
                const u32x4 v = xr[3 + rr];
                float xc[8]; xc[0] = bflo(v.x); xc[1] = bfhi(v.x); xc[2] = bflo(v.y); xc[3] = bfhi(v.y); xc[4] = bflo(v.z); xc[5] = bfhi(v.z); xc[6] = bflo(v.w); xc[7] = bfhi(v.w);
                float y[8];
#pragma unroll
                for (int e = 0; e < 8; ++e) { y[e] = cb[e] + xw[0][e] * cw[0][e] + xw[1][e] * cw[1][e] + xw[2][e] * cw[2][e] + xc[e] * cw[3][e]; xw[0][e] = xw[1][e]; xw[1][e] = xw[2][e]; xw[2][e] = xc[e]; }
                u32x4 o; o.x = pk2(y[0], y[1]); o.y = pk2(y[2], y[3]); o.z = pk2(y[4], y[5]); o.w = pk2(y[6], y[7]);
                *(LAS u32x4*)(lds + L_XC + (run * 8 + rr) * XC_PITCH + c16 * 16) = o; }
        }
        if (tile + 1 < ntiles) {
#pragma unroll
            for (int k = 0; k < 11; ++k) xr[k] = *(const u32x4*)(Xr + (size_t)(Rbase + (tile + 1) * 256 + run * 8 - 3 + k) * 1024 + ch0); }
        __syncthreads();
        f32x16 aA[2], aX[2];
#pragma unroll
        for (int ct = 0; ct < 2; ++ct)
#pragma unroll
            for (int e = 0; e < 16; ++e) { aA[ct][e] = 0.f; aX[ct][e] = 0.f; }
#pragma unroll
        for (int s = 0; s < 8; ++s) { const bf16x8 a = *(const LAS bf16x8*)(lds + L_XC + (32 * w + r) * XC_PITCH + (16 * s + 8 * hh) * 2);
#pragma unroll
            for (int ct = 0; ct < 2; ++ct) { const bf16x8 b0 = *(const LAS bf16x8*)(lds + L_WA + (ct * 32 + r) * WG_PITCH + (16 * s + 8 * hh) * 2), b1 = *(const LAS bf16x8*)(lds + L_WX + (ct * 32 + r) * WG_PITCH + (16 * s + 8 * hh) * 2);
                aA[ct] = mfma32(a, b0, aA[ct]); aX[ct] = mfma32(a, b1, aX[ct]); } }
        float myc[2];
#pragma unroll
        for (int ct = 0; ct < 2; ++ct) {
            const int cl = jh * 64 + ct * 32 + r;
#pragma unroll
            for (int e = 0; e < 16; ++e) { const int tl = 32 * w + (e & 3) + 8 * (e >> 2) + 4 * hh;
                const float rg = sigmoidf_(aA[ct][e] + ba[ct]), ig = sigmoidf_(aX[ct][e] + bx[ct]);
                float a = __builtin_amdgcn_exp2f(rg * sp[ct]); const float mult = __builtin_amdgcn_sqrtf(fmaxf(1.0f - a * a, 0.f));
                const float xcv = bf1(*(const LAS bf16_t*)(lds + L_XC + tl * XC_PITCH + cl * 2));
                float uu = mult * ig * xcv;
                if (tl >= nvalid) { a = 1.0f; uu = 0.f; }
                aA[ct][e] = a; aX[ct][e] = uu; }
            float Ag[4], Hg[4], pA[4], pH[4];
#pragma unroll
            for (int g = 0; g < 4; ++g) {
#pragma unroll
                for (int i = 1; i < 4; ++i) { aX[ct][4 * g + i] = aA[ct][4 * g + i] * aX[ct][4 * g + i - 1] + aX[ct][4 * g + i]; aA[ct][4 * g + i] = aA[ct][4 * g + i] * aA[ct][4 * g + i - 1]; }
                Ag[g] = aA[ct][4 * g + 3]; Hg[g] = aX[ct][4 * g + 3]; pA[g] = __shfl_xor(Ag[g], 32); pH[g] = __shfl_xor(Hg[g], 32); }
            float s = 0.f, q = 1.f, cg_[4], qg[4];
#pragma unroll
            for (int g = 0; g < 4; ++g) {
                if (hh == 0) { cg_[g] = s; qg[g] = q; s = Ag[g] * s + Hg[g]; q *= Ag[g]; s = pA[g] * s + pH[g]; q *= pA[g]; }
                else { s = pA[g] * s + pH[g]; q *= pA[g]; cg_[g] = s; qg[g] = q; s = Ag[g] * s + Hg[g]; q *= Ag[g]; } }
#pragma unroll
            for (int e = 0; e < 16; ++e) { aX[ct][e] += aA[ct][e] * cg_[e >> 2]; aA[ct][e] *= qg[e >> 2]; }
            if (hh == 0) *(LAS f32x2*)(lds + L_AGG + (w * 64 + ct * 32 + r) * 8) = (f32x2){q, s};
        }
        __syncthreads();
#pragma unroll
        for (int ct = 0; ct < 2; ++ct) { float c = carry[ct]; myc[ct] = c;
#pragma unroll
            for (int w2 = 0; w2 < 8; ++w2) { const f32x2 ag = *(const LAS f32x2*)(lds + L_AGG + (w2 * 64 + ct * 32 + r) * 8); if (w2 == w) myc[ct] = c; c = ag.x * c + ag.y; }
            carry[ct] = c;
            const int ch = n * 128 + jh * 64 + ct * 32 + r;
#pragma unroll
            for (int e = 0; e < 16; ++e) { const int tl = 32 * w + (e & 3) + 8 * (e >> 2) + 4 * hh;
                const float hv = aX[ct][e] + aA[ct][e] * myc[ct];
                if (tl < nvalid) Hs[(size_t)(R0 + tl) * 1024 + ch] = (bf16_t)(pk2(hv, hv) & 0xffffu); } }
    }
    if (w == 0 && hh == 0) {
#pragma unroll
        for (int ct = 0; ct < 2; ++ct) hlast[n * 128 + jh * 64 + ct * 32 + r] = carry[ct];
    }
}

__device__ __forceinline__ void phase2(const Params& P, LAS unsigned char* lds) {
    unsigned char* ws = P.ws;
    const int tid = my_tid(), lane = tid & 63, wave = tid >> 6;
    const int gw = blockIdx.x * 8 + wave, ngw = gridDim.x * 8;
    const size_t gt = (size_t)blockIdx.x * 512 + tid, ngt = (size_t)gridDim.x * 512;
    { f32x4 gk[2]; gk[0] = ((const f32x4*)P.kv_norm_g)[lane]; gk[1] = ((const f32x4*)P.kv_norm_g)[lane + 64];
      for (int R0 = gw; R0 < MT; R0 += 4 * ngw) {
        u32x2 r0[4], r1[4]; float sq[4];
#pragma unroll
        for (int u = 0; u < 4; ++u) { const int R = R0 + u * ngw; const int Rc = R < MT ? R : 0;
            const u32x2* o = (const u32x2*)(ws + R_D + (size_t)Rc * 1024) + lane; r0[u] = o[0]; r1[u] = o[64]; sq[u] = ((const float*)(ws + W_SSQ_CKV))[Rc]; }
#pragma unroll
        for (int u = 0; u < 4; ++u) { const int R = R0 + u * ngw;
            if (R < MT) { u32x2* o = (u32x2*)(ws + R_D + (size_t)R * 1024) + lane;
                if (R < MP + MS) {
                    f32x4* xr = (f32x4*)(R < MP ? P.out + O_CKVP + (size_t)R * 512 : P.out + O_CKVS + (size_t)(R - MP) * 512) + lane;
                    const float rs = __builtin_amdgcn_rsqf(sq[u] * (1.0f / 512.0f) + EPS);
                    f32x4 v0 = (f32x4){bflo(r0[u].x), bfhi(r0[u].x), bflo(r0[u].y), bfhi(r0[u].y)} * rs * gk[0], v1 = (f32x4){bflo(r1[u].x), bfhi(r1[u].x), bflo(r1[u].y), bfhi(r1[u].y)} * rs * gk[1];
                    xr[0] = v0; xr[64] = v1;
                    o[0] = (u32x2){pk2(v0.x, v0.y), pk2(v0.z, v0.w)}; o[64] = (u32x2){pk2(v1.x, v1.y), pk2(v1.z, v1.w)};
                } else { o[0] = (u32x2){0u, 0u}; o[64] = (u32x2){0u, 0u}; } } }
      } }
#pragma unroll 4
    for (size_t i = gt; i < (size_t)MT * 32; i += ngt) { const int R = (int)(i >> 5), j = (int)(i & 31);
        if (R < MP + MS) kr_row<true>(P, R < MP ? P.out + O_KRP + (size_t)R * 64 : P.out + O_KRS + (size_t)(R - MP) * 64, tok_pos(R), (bf16_t*)(ws + W_KR) + (size_t)R * 64, (float*)(ws + W_SSQ_KR) + R, j);
        else { ((unsigned*)(ws + W_KR))[(size_t)R * 32 + j] = 0u; if (j == 0) ((float*)(ws + W_SSQ_KR))[R] = 0.f; } }
    for (size_t i = gt; i < (size_t)(NB + SB) * 3 * 1024; i += ngt) { const int c = (int)(i & 1023), j = (int)((i >> 10) % 3), b = (int)(i / 3072);
        const bf16_t* Xr = (const bf16_t*)(ws + R_B);
        if (b < NB) P.out[O_CONVP + (size_t)b * 3072 + j * 1024 + c] = bf1(Xr[(size_t)(b * SEQ + SEQ - 3 + j) * 1024 + c]);
        else P.out[O_CONVS + (size_t)(b - NB) * 3072 + j * 1024 + c] = bf1(Xr[(size_t)(MP + (b - NB) * ST + ST - 3 + j) * 1024 + c]); }
    for (int it = blockIdx.x; it < 256 + 128; it += gridDim.x) {
        if (it < 256) { const int b = it >> 4, n = (it >> 1) & 7, jh = it & 1; rnn_chain(P, lds, b * SEQ, SEQ / 256, 256, n, jh, nullptr, nullptr, P.out + O_HP + (size_t)b * 1024); }
        else { const int k = it - 256, b = k >> 4, n = (k >> 1) & 7, jh = k & 1; rnn_chain(P, lds, MP + b * ST, 1, ST, n, jh, P.state_conv + (size_t)b * 3072, P.state_h + (size_t)b * 1024, P.out + O_HS + (size_t)b * 1024); }
    }
}

constexpr int KBUF = 64 * 384, VBUF = 128 * 128;
constexpr int L_K0 = 0, L_V0 = 2 * KBUF, L_RKT = L_V0 + 2 * VBUF;

struct AttnStage { unsigned kofs[3], kstr[3], vofs[2]; };
__device__ __forceinline__ void attn_stage_init(AttnStage& st, int h, int tid) {
    const int w = tid >> 6, lane = tid & 63;
#pragma unroll
    for (int i = 0; i < 3; ++i) { const int q = (w * 3 + i) * 64 + lane, key = q / 24, slot = q % 24, p = slot ^ ((key >> 1) & 7);
        st.kstr[i] = p >= 16 ? 128u : 2048u;
        st.kofs[i] = p >= 16 ? (unsigned)(W_KR + key * 128 + (p - 16) * 16) : (unsigned)(R_F + key * 2048 + h * 256 + p * 16); }
#pragma unroll
    for (int i = 0; i < 2; ++i) { const int q = (w * 2 + i) * 64 + lane, d = q >> 3, slot = q & 7, p = slot ^ ((d >> 1) & 7);
        st.vofs[i] = (unsigned)R_G + (unsigned)(h * 128 + d) * (unsigned)(MKV * 2) + p * 16; }
}
__device__ __forceinline__ void attn_stage_issue(const Params& P, LAS unsigned char* lds, const AttnStage& st, int R0, int buf, int tid) {
    const char* ws = (const char*)P.ws; const int w = __builtin_amdgcn_readfirstlane(tid >> 6);
#pragma unroll
    for (int i = 0; i < 3; ++i) __builtin_amdgcn_global_load_lds((const unsigned*)(ws + (st.kofs[i] + (unsigned)R0 * st.kstr[i])), (LAS unsigned*)(lds + L_K0 + buf * KBUF + (w * 3 + i) * 1024), 16, 0, 0);
#pragma unroll
    for (int i = 0; i < 2; ++i) __builtin_amdgcn_global_load_lds((const unsigned*)(ws + (st.vofs[i] + (unsigned)R0 * 2u)), (LAS unsigned*)(lds + L_V0 + buf * VBUF + (w * 2 + i) * 1024), 16, 0, 0);
}
__device__ __forceinline__ u32x4 scale8(u32x4 v, float s) { u32x4 o; o.x = pk2(bflo(v.x) * s, bfhi(v.x) * s); o.y = pk2(bflo(v.y) * s, bfhi(v.y) * s); o.z = pk2(bflo(v.z) * s, bfhi(v.z) * s); o.w = pk2(bflo(v.w) * s, bfhi(v.w) * s); return o; }
template <bool NOMAX>
__device__ __forceinline__ void attn_block(const Params& P, LAS unsigned char* lds, int qR0, int h, int kR0, int kR1, int ntiles, int jmax, int nlast, int qvalid) {
    unsigned char* ws = P.ws;
    const int tid = my_tid(), lane = tid & 63, w = tid >> 6, r = lane & 31, hh = lane >> 5, x = (r >> 1) & 7;
    const int qR = qR0 + 32 * w + r;
    AttnStage st; attn_stage_init(st, h, tid);
    attn_stage_issue(P, lds, st, kR0, 0, tid);
    int oc[4];
#pragma unroll
    for (int c4 = 0; c4 < 4; ++c4) oc[c4] = ((2 * c4 + hh) ^ x) << 4;
    bf16x8 qf[12];
    { const float qs = QSCALE * __builtin_amdgcn_rsqf(((const float*)(ws + W_SSQ_Q))[(size_t)qR * 8 + h] * (1.0f / 192.0f) + EPS);
        const bf16_t* q = (const bf16_t*)(ws + R_A) + (size_t)qR * 1536 + h * 192 + 8 * hh;
#pragma unroll
        for (int s = 0; s < 12; ++s) { const u32x4 v = scale8(*(const u32x4*)(q + 16 * s), qs); qf[s] = *(const bf16x8*)&v; } }
    f32x16 oacc[4];
#pragma unroll
    for (int dt = 0; dt < 4; ++dt)
#pragma unroll
        for (int e = 0; e < 16; ++e) oacc[dt][e] = 0.f;
    float mrun = -1e30f, lrun = 0.f;
    asm volatile("s_waitcnt vmcnt(0)" ::: "memory");
    __syncthreads();
    for (int j = 0; j < ntiles; ++j) {
        const int buf = j & 1;
        if (j + 1 < ntiles) { const int Rn = (kR1 >= 0 && j + 1 >= 16) ? kR1 : kR0 + 64 * (j + 1);
            attn_stage_issue(P, lds, st, Rn, buf ^ 1, tid); }
        if (j <= jmax) {
            const LAS unsigned char* kb = lds + L_K0 + buf * KBUF + r * 384; const LAS unsigned char* vb = lds + L_V0 + buf * VBUF + r * 128;
            const LAS unsigned char* rkb = lds + L_RKT + j * 256 + 16 * hh;
            f32x16 sacc[2];
#pragma unroll
            for (int kt = 0; kt < 2; ++kt) {
#pragma unroll
                for (int e = 0; e < 16; ++e) sacc[kt][e] = 0.f;
#pragma unroll
                for (int s = 0; s < 12; ++s) { const bf16x8 kf = *(const LAS bf16x8*)(kb + kt * (32 * 384) + (s >> 2) * 128 + oc[s & 3]); sacc[kt] = mfma32(kf, qf[s], sacc[kt]); }
            }
#pragma unroll
            for (int kt = 0; kt < 2; ++kt)
#pragma unroll
                for (int gq = 0; gq < 4; ++gq) { const f32x4 rk4 = *(const LAS f32x4*)(rkb + (32 * kt + 8 * gq) * 4);
#pragma unroll
                    for (int i = 0; i < 4; i += 2) { f32x2 t = (f32x2){sacc[kt][4 * gq + i], sacc[kt][4 * gq + i + 1]} * (f32x2){rk4[i], rk4[i + 1]};
                        sacc[kt][4 * gq + i] = t.x; sacc[kt][4 * gq + i + 1] = t.y; } }
            if (j == ntiles - 1 && nlast < 64) {
#pragma unroll
                for (int kt = 0; kt < 2; ++kt)
#pragma unroll
                    for (int e = 0; e < 16; ++e) { const int key = 32 * kt + (e & 3) + 8 * (e >> 2) + 4 * hh; if (key >= nlast) sacc[kt][e] = -1e30f; } }
            float mnew = 0.f;
            if constexpr (!NOMAX) {
                float mx = sacc[0][0];
#pragma unroll
                for (int kt = 0; kt < 2; ++kt)
#pragma unroll
                    for (int e = 0; e < 16; ++e) mx = fmaxf(mx, sacc[kt][e]);
                mx = fmaxf(mx, __shfl_xor(mx, 32));
                const float mcand = fmaxf(mrun, mx);
                if (__any(mcand > mrun + 8.0f)) { const float alpha = __builtin_amdgcn_exp2f(mrun - mcand); lrun *= alpha;
#pragma unroll
                    for (int dt = 0; dt < 4; ++dt)
#pragma unroll
                        for (int e = 0; e < 16; ++e) oacc[dt][e] *= alpha;
                    mrun = mcand; }
                mnew = mrun;
            }
            f32x2 ps2 = (f32x2){0.f, 0.f};
#pragma unroll
            for (int kt = 0; kt < 2; ++kt)
#pragma unroll
                for (int e = 0; e < 16; e += 2) { f32x2 a2 = (f32x2){sacc[kt][e], sacc[kt][e + 1]};
                    if constexpr (!NOMAX) a2 = a2 - (f32x2){mnew, mnew};
                    f32x2 p2; p2.x = __builtin_amdgcn_exp2f(a2.x); p2.y = __builtin_amdgcn_exp2f(a2.y);
                    sacc[kt][e] = p2.x; sacc[kt][e + 1] = p2.y; ps2 = ps2 + p2; }
            lrun += ps2.x + ps2.y;
            bf16x8 pf[2][2];
#pragma unroll
            for (int kt = 0; kt < 2; ++kt)
#pragma unroll
                for (int s2 = 0; s2 < 2; ++s2) { u32x4 v; v.x = pk2(sacc[kt][8 * s2 + 0], sacc[kt][8 * s2 + 1]); v.y = pk2(sacc[kt][8 * s2 + 2], sacc[kt][8 * s2 + 3]); v.z = pk2(sacc[kt][8 * s2 + 4], sacc[kt][8 * s2 + 5]); v.w = pk2(sacc[kt][8 * s2 + 6], sacc[kt][8 * s2 + 7]); pf[kt][s2] = *(const bf16x8*)&v; }
#pragma unroll
            for (int dt = 0; dt < 4; ++dt)
#pragma unroll
                for (int kt = 0; kt < 2; ++kt)
#pragma unroll
                    for (int s2 = 0; s2 < 2; ++s2) { const bf16x8 vf = *(const LAS bf16x8*)(vb + dt * (32 * 128) + oc[2 * kt + s2]);
                        oacc[dt] = mfma32(vf, pf[kt][s2], oacc[dt]); }
        }
        asm volatile("s_waitcnt vmcnt(0)" ::: "memory");
        __syncthreads();
    }
    if (jmax >= 0) {
        const float l = lrun + __shfl_xor(lrun, 32), inv = __builtin_amdgcn_rcpf(l);
        if (r < qvalid) { bf16_t* o = (bf16_t*)(ws + R_H) + (size_t)qR * 1024 + h * 128 + 4 * hh;
#pragma unroll
            for (int dt = 0; dt < 4; ++dt)
#pragma unroll
                for (int gq = 0; gq < 4; ++gq) { u32x2 v; v.x = pk2(oacc[dt][4 * gq] * inv, oacc[dt][4 * gq + 1] * inv); v.y = pk2(oacc[dt][4 * gq + 2] * inv, oacc[dt][4 * gq + 3] * inv); *(u32x2*)(o + 32 * dt + 8 * gq) = v; } }
    }
}
__device__ __forceinline__ void phase4(const Params& P, LAS unsigned char* lds) {
    const unsigned char* ws = P.ws;
    const int tid = my_tid(), w = tid >> 6;
    const float* sk = (const float*)(ws + W_SSQ_K); const float* skr = (const float*)(ws + W_SSQ_KR);
    bool nomax;
    { const int l = tid & 63; float gq = 0.f, gk = 0.f;
#pragma unroll
      for (int i = 0; i < 3; ++i) { gq = fmaxf(gq, fabsf(P.qk_q_g[l + 64 * i])); gk = fmaxf(gk, fabsf(P.qk_k_g[l + 64 * i])); }
#pragma unroll
      for (int o = 1; o < 64; o <<= 1) { gq = fmaxf(gq, __shfl_xor(gq, o)); gk = fmaxf(gk, __shfl_xor(gk, o)); }
      nomax = __builtin_amdgcn_readfirstlane((192.0f * QSCALE * gq * gk <= 60.0f) ? 1 : 0) != 0; }
    for (int it = blockIdx.x; it < 1024 + 64; it += gridDim.x) {
        if (it < 1024) {
            const int cc = it & 255, kk = it >> 8, bh = ((kk * 4 + (cc >> 6)) << 3) + (cc & 7), i = (cc >> 3) & 7, b = bh >> 3, h = bh & 7;
            for (int key = tid; key < (16 - i) * 256; key += 512) { const int R = b * SEQ + key; *(LAS float*)(lds + L_RKT + key * 4) = __builtin_amdgcn_rsqf((sk[(size_t)R * 8 + h] + skr[R]) * (1.0f / 192.0f) + EPS); }
            __syncthreads();
#pragma unroll 1
            for (int k = 0; k < 2; ++k) { const int blk = k ? i : 15 - i;
                if (nomax) attn_block<true>(P, lds, b * SEQ + blk * 256, h, b * SEQ, -1, 4 * blk + 4, 4 * blk + (w >> 1), 64, 32);
                else attn_block<false>(P, lds, b * SEQ + blk * 256, h, b * SEQ, -1, 4 * blk + 4, 4 * blk + (w >> 1), 64, 32); }
        } else { const int k = it - 1024, b = k >> 3, h = k & 7;
            for (int key = tid; key < 1088; key += 512) { const int R = key < PAST ? R_PAST0 + b * PAST + key : MP + b * ST + (key - PAST); *(LAS float*)(lds + L_RKT + key * 4) = __builtin_amdgcn_rsqf((sk[(size_t)R * 8 + h] + skr[R]) * (1.0f / 192.0f) + EPS); }
            __syncthreads();
            if (nomax) attn_block<true>(P, lds, MP + b * ST, h, R_PAST0 + b * PAST, MP + b * ST, 17, w == 0 ? 16 : -1, ST, ST);
            else attn_block<false>(P, lds, MP + b * ST, h, R_PAST0 + b * PAST, MP + b * ST, 17, w == 0 ? 16 : -1, ST, ST); }
    }
}

#define XB_TMO      128
#define XB_XCNT(j)  (256  + 64 * (j))
#define XB_XSUB(j)  (1280 + 64 * (j))
#define XB_XGEN(j)  (2304 + 64 * (j))
#define XB_TOP      3328
#define XB_TOPGEN   3392
#define XCD_BAR_WORDS 3456
#define XB_SPIN_CAP (1u << 18)
__device__ __forceinline__ unsigned xb_ld(unsigned* p)              { return __hip_atomic_load(p, __ATOMIC_RELAXED, __HIP_MEMORY_SCOPE_AGENT); }
__device__ __forceinline__ unsigned xb_add(unsigned* p, unsigned v) { return __hip_atomic_fetch_add(p, v, __ATOMIC_RELAXED, __HIP_MEMORY_SCOPE_AGENT); }
__device__ __forceinline__ unsigned xb_xcc_id() { return (unsigned)__builtin_amdgcn_s_getreg((3 << 11) | 20) & 0xFu; }
#define XB_SPIN(cond, bar) do { unsigned _sp = 0; while (cond) { __builtin_amdgcn_s_sleep(1); \
    if ((++_sp & 255u) == 0u) { if (xb_ld(&(bar)[XB_TMO])) break; if (_sp > XB_SPIN_CAP) { atomicAdd(&(bar)[XB_TMO], 1u); break; } } } } while (0)
__device__ __forceinline__ void xcd_barrier_complete(unsigned* bar, unsigned x, unsigned& nloc, unsigned& nx) {
    const unsigned G = gridDim.x * gridDim.y * gridDim.z;
    unsigned sum, cnt, mine, sp = 0u;
    for (;;) {
        sum = 0u; cnt = 0u; mine = 0u;
#pragma unroll
        for (unsigned j = 0; j < 16; ++j) { const unsigned c = xb_ld(&bar[XB_XCNT(j)]); sum += c; cnt += (c > 0u) ? 1u : 0u; mine = (j == x) ? c : mine; }
        if (sum == G) break;
        __builtin_amdgcn_s_sleep(1);
        if ((++sp & 255u) == 0u) { if (xb_ld(&bar[XB_TMO])) break; if (sp > XB_SPIN_CAP) { atomicAdd(&bar[XB_TMO], 1u); break; } }
    }
    nloc = mine > 0u ? mine : 1u; nx = cnt > 0u ? cnt : 1u;
}
__device__ __forceinline__ void xcd_barrier(unsigned* bar, volatile LAS unsigned* st) {
    asm volatile("s_waitcnt vmcnt(0)" ::: "memory");
    __syncthreads();
    if (threadIdx.x == 0) {
        const unsigned x = xb_xcc_id();
        __builtin_amdgcn_s_waitcnt(0);
        unsigned nloc = st[0], nx = st[1];
        if (nloc == 0u) { xcd_barrier_complete(bar, x, nloc, nx); st[0] = nloc; st[1] = nx; }
        const unsigned old = xb_add(&bar[XB_XSUB(x)], 1u);
        const unsigned gen = old / nloc;
        if (old + 1u == (gen + 1u) * nloc) {
            __builtin_amdgcn_fence(__ATOMIC_RELEASE, "agent");
            asm volatile("s_waitcnt vmcnt(0)" ::: "memory");
            const unsigned og = xb_add(&bar[XB_TOP], 1u);
            const unsigned tg = og / nx;
            if (og + 1u == (tg + 1u) * nx) xb_add(&bar[XB_TOPGEN], 1u);
            else XB_SPIN(xb_ld(&bar[XB_TOPGEN]) == tg, bar);
            __builtin_amdgcn_fence(__ATOMIC_ACQUIRE, "agent");
            xb_add(&bar[XB_XGEN(x)], 1u);
            asm volatile("s_waitcnt vmcnt(0)" ::: "memory");
        } else {
            XB_SPIN(xb_ld(&bar[XB_XGEN(x)]) == gen, bar);
            __builtin_amdgcn_fence(__ATOMIC_ACQUIRE, "agent");
            asm volatile("s_waitcnt vmcnt(0)" ::: "memory");
        }
    }
    __syncthreads();
}

typedef const __attribute__((address_space(4))) Params* KArgs;
#if defined(__HIP_DEVICE_COMPILE__)
#define LOAD_PARAMS() KArgs kp_ = (KArgs)__builtin_amdgcn_kernarg_segment_ptr(); asm volatile("" : "+s"(kp_)); const Params P = *kp_; unsigned char* ws = P.ws
#else
#define LOAD_PARAMS() const Params P = Pk; unsigned char* ws = P.ws
#endif
__global__ void __launch_bounds__(512, 2) fwd_megakernel(Params Pk) {
    extern __shared__ __attribute__((aligned(16))) unsigned char lds_raw[];
    LAS unsigned char* lds = (LAS unsigned char*)lds_raw;
    cg::grid_group grid = cg::this_grid();
    const int G = gridDim.x, c = blockIdx.x;
    volatile LAS unsigned* xst = (volatile LAS unsigned*)(lds + L_XB);
    if (threadIdx.x == 0) { xst[0] = 0u; xst[1] = 0u; }
    __syncthreads();
    { LOAD_PARAMS(); if (threadIdx.x == 0) (void)xb_add(&((unsigned*)(ws + W_BAR))[XB_XCNT(xb_xcc_id())], 1u); }
#define GRID_BARRIER() do { LOAD_PARAMS(); (void)P; xcd_barrier((unsigned*)(ws + W_BAR), xst); } while (0)
#ifndef PHM
#define PHM 0x1ff
#endif
    if (PHM & 1) { LOAD_PARAMS(); (void)ws; phase0(P, lds); }
    grid.sync();
    if (PHM & 2) { LOAD_PARAMS(); pg8::Order<1, 1, R_A, W_IN, MT / 256, NIN / 256> S{ws, G, c}; Epi<1> E{P}; pg8::gemm_phase(lds, 1024, S, E); }
    GRID_BARRIER();
    if (PHM & 4) { LOAD_PARAMS(); (void)ws; phase2(P, lds); }
    GRID_BARRIER();
    if (PHM & 8) { LOAD_PARAMS(); pg8::Order<3, 1, R_C, W_UQ, MT / 256, 6, R_D, W_UK, MKV / 256, 4, W_UV, R_D, 4, MKV / 256> S{ws, G, c}; Epi<3> E{P}; pg8::gemm_phase(lds, 512, S, E); }
    GRID_BARRIER();
    if (PHM & 16) { LOAD_PARAMS(); (void)ws; phase4(P, lds); }
    GRID_BARRIER();
    if (PHM & 32) { LOAD_PARAMS(); pg8::Order<1, 2, R_H, W_PA, MT / 256, 4, R_E, W_PR> S{ws, G, c}; Epi<5> E{P}; pg8::gemm_phase(lds, 1024, S, E); }
    GRID_BARRIER();
    if (PHM & 64) { LOAD_PARAMS(); pg8::Order<1, 1, R_C, W_OUT, MT / 256, 4> S{ws, G, c}; Epi<6> E{P}; pg8::gemm_phase(lds, 1024, S, E); }
    GRID_BARRIER();
    if (PHM & 128) { LOAD_PARAMS(); pg8::Order<1, 1, R_E, W_GU, MT / 256, 22> S{ws, G, c}; Epi<7> E{P}; pg8::gemm_phase(lds, 1024, S, E); }
    GRID_BARRIER();
    if (PHM & 256) { LOAD_PARAMS(); pg8::Order<1, 1, R_A, W_D, MT / 256, 4> S{ws, G, c}; Epi<8> E{P}; pg8::gemm_phase(lds, DFF, S, E); }
}

extern "C" void kernel_launch(void* const* d_in, const int* in_sizes, int n_in, void* d_out, int out_size, void* d_ws, size_t ws_size, hipStream_t stream) {
    static int grid = 0;
    if (grid == 0) {
        if (n_in != 28 || (size_t)out_size != O_END || ws_size < WS_END) { fprintf(stderr, "kernel_launch: unexpected shapes (n_in %d out %d ws %zu need %zu)\n", n_in, out_size, ws_size, (size_t)WS_END); grid = -1; return; }
        int dev = 0, cus = 0, per_cu = 0;
        hipGetDevice(&dev); hipDeviceGetAttribute(&cus, hipDeviceAttributeMultiprocessorCount, dev);
        if (hipFuncSetAttribute((const void*)fwd_megakernel, hipFuncAttributeMaxDynamicSharedMemorySize, LDS_BYTES) != hipSuccess) { fprintf(stderr, "kernel_launch: hipFuncSetAttribute failed\n"); grid = -1; return; }
        hipOccupancyMaxActiveBlocksPerMultiprocessor(&per_cu, (const void*)fwd_megakernel, 512, LDS_BYTES);
        if (per_cu < 1) { fprintf(stderr, "kernel_launch: occupancy query says %d blocks per CU\n", per_cu); per_cu = 1; }
        (void)hipGetLastError();
        grid = cus;
    }
    if (grid < 0) return;
    Params p{};
    const float** f = (const float**)&p;
    for (int i = 0; i < 28; ++i) f[i] = (const float*)d_in[i];
    p.out = (float*)d_out; p.ws = (unsigned char*)d_ws;
    if (hipMemsetAsync((char*)d_ws + W_BAR, 0, 16384, stream) != hipSuccess) { fprintf(stderr, "kernel_launch: memset of the barrier words failed\n"); return; }
    void* args[] = {&p};
    hipError_t e = hipLaunchCooperativeKernel((const void*)fwd_megakernel, dim3(grid), dim3(512), args, LDS_BYTES, stream);
    if (e != hipSuccess) fprintf(stderr, "cooperative launch failed: %s (grid %d)\n", hipGetErrorString(e), grid);
}
```
